# Optimizing an MI355X kernel written in HIP

```python
import math
import jax, jax.numpy as jnp
from jax import lax
import numpy as np

D_MODEL = 2048
BATCH = 2
SEQ = 8192
DEPTH = 1

QK_NOPE_DIM = 128
QK_ROPE_DIM = 64
V_HEAD_DIM = 128
N_HEADS = D_MODEL // V_HEAD_DIM
Q_LORA_RANK = 512
KV_LORA_RANK = 512
QK_HEAD_DIM = QK_NOPE_DIM + QK_ROPE_DIM
ROPE_THETA = 10000.0
Q_BLOCK = 128

POOL_WINDOWS = (2, 4, 8, 16)
POOL_GROUPS = len(POOL_WINDOWS)
POOL_WIDTH = D_MODEL // 2
POOL_GROUP_DIM = POOL_WIDTH // POOL_GROUPS
POOL_OUT_GROUP_DIM = D_MODEL // POOL_GROUPS

OFF_Q = 0
OFF_KV = OFF_Q + Q_LORA_RANK
OFF_KR = OFF_KV + KV_LORA_RANK
OFF_POOL = OFF_KR + QK_ROPE_DIM
OFF_GA = OFF_POOL + POOL_WIDTH
OFF_GP = OFF_GA + D_MODEL
IN_PROJ_WIDTH = OFF_GP + D_MODEL

N_EXPERTS = 32
TOP_K = 4
D_FF = D_MODEL
SWIGLU_LIMIT = 7.0
SWIGLU_ALPHA = 1.702
EXPERT_BLOCK = 128

RMS_EPS = 1e-6
NEG_INF = -1e30

kernel_name = "hybrid_mla_pool_moe_layer"


def rms_norm(t, gain):
    t32 = t.astype(jnp.float32)
    t32 = t32 * lax.rsqrt(jnp.mean(t32 * t32, axis=-1, keepdims=True) + RMS_EPS)
    return (t32 * gain.astype(jnp.float32)).astype(t.dtype)


def rope(t, cos, sin):
    half = t.shape[-1] // 2
    t32 = t.astype(jnp.float32)
    t1, t2 = t32[..., :half], t32[..., half:]
    out = jnp.concatenate([t1 * cos - t2 * sin, t2 * cos + t1 * sin], axis=-1)
    return out.astype(t.dtype)


def mla_branch(zq, zkv, zkr, positions, g_q_latent, w_uq, g_kv_latent, w_ukv,
               g_q_nope, g_q_rope, g_k_nope, g_k_rope):
    B, S, _ = zq.shape
    q = rms_norm(zq, g_q_latent) @ w_uq
    q = q.reshape(B, S, N_HEADS, QK_HEAD_DIM)
    q_nope, q_pe = q[..., :QK_NOPE_DIM], q[..., QK_NOPE_DIM:]
    kv = rms_norm(zkv, g_kv_latent) @ w_ukv
    kv = kv.reshape(B, S, N_HEADS, QK_NOPE_DIM + V_HEAD_DIM)
    k_nope, v = kv[..., :QK_NOPE_DIM], kv[..., QK_NOPE_DIM:]
    q_nope = rms_norm(q_nope, g_q_nope)
    q_pe = rms_norm(q_pe, g_q_rope)
    k_nope = rms_norm(k_nope, g_k_nope)
    k_pe = rms_norm(zkr, g_k_rope)
    inv_freq = ROPE_THETA ** (-jnp.arange(0, QK_ROPE_DIM, 2, dtype=jnp.float32) / QK_ROPE_DIM)
    ang = positions.astype(jnp.float32)[..., None] * inv_freq
    cos, sin = jnp.cos(ang), jnp.sin(ang)
    q_pe = rope(q_pe, cos[:, :, None, :], sin[:, :, None, :])
    k_pe = rope(k_pe, cos, sin)

    scale = 1.0 / math.sqrt(QK_HEAD_DIM)
    n_qb = S // Q_BLOCK
    qn_blocks = q_nope.reshape(B, n_qb, Q_BLOCK, N_HEADS, QK_NOPE_DIM).transpose(1, 0, 2, 3, 4)
    qp_blocks = q_pe.reshape(B, n_qb, Q_BLOCK, N_HEADS, QK_ROPE_DIM).transpose(1, 0, 2, 3, 4)
    k_pos = jnp.arange(S)

    def attn_block(args):
        qn_b, qp_b, i = args
        s = jnp.einsum('bqhd,bkhd->bhqk', qn_b, k_nope, preferred_element_type=jnp.float32)
        s = s + jnp.einsum('bqhr,bkr->bhqk', qp_b, k_pe, preferred_element_type=jnp.float32)
        q_pos = i * Q_BLOCK + jnp.arange(Q_BLOCK)
        causal = k_pos[None, :] <= q_pos[:, None]
        s = jnp.where(causal, s * scale, NEG_INF)
        p = jax.nn.softmax(s, axis=-1).astype(v.dtype)
        return jnp.einsum('bhqk,bkhd->bqhd', p, v)

    o = lax.map(attn_block, (qn_blocks, qp_blocks, jnp.arange(n_qb)))
    return o.transpose(1, 0, 2, 3, 4).reshape(B, S, N_HEADS * V_HEAD_DIM)


def pool_branch(u, w_pool, s_pool):
    B, S, _ = u.shape
    ug = u.reshape(B, S, POOL_GROUPS, POOL_GROUP_DIM)
    cs = jnp.cumsum(ug.astype(jnp.float32), axis=1)
    cs0 = jnp.concatenate([jnp.zeros((B, 1, POOL_GROUPS, POOL_GROUP_DIM), jnp.float32), cs], axis=1)
    windows = jnp.array(POOL_WINDOWS, dtype=jnp.int32)
    hi = jnp.arange(1, S + 1, dtype=jnp.int32)[:, None]
    lo = jnp.maximum(hi - windows[None, :], 0)
    count = (hi - lo).astype(jnp.float32)
    g_idx = jnp.arange(POOL_GROUPS)[None, :]
    window_sum = cs - cs0[:, lo, g_idx]
    pooled = (window_sum / count[None, :, :, None]).astype(u.dtype) - ug
    y = jnp.einsum('bsgc,gcd->bsgd', pooled, w_pool).reshape(B, S, D_MODEL)
    return y * s_pool


def moe_ffn(h, w_router, b_router, w_gate_up, b_gate_up, w_down, b_down):
    T, D = h.shape
    logits = jnp.dot(h, w_router, preferred_element_type=jnp.float32) + b_router.astype(jnp.float32)
    top_vals, top_idx = lax.top_k(logits, TOP_K)
    gates = jax.nn.softmax(top_vals, axis=-1)
    A = T * TOP_K
    e_flat = top_idx.reshape(A)
    order = jnp.argsort(e_flat, stable=True)
    e_sorted = e_flat[order]
    tok_sorted = (order // TOP_K).astype(jnp.int32)
    w_sorted = gates.reshape(A)[order]
    counts = jnp.bincount(e_flat, length=N_EXPERTS)
    starts = jnp.cumsum(counts) - counts
    padded = (counts + EXPERT_BLOCK - 1) // EXPERT_BLOCK * EXPERT_BLOCK
    pends = jnp.cumsum(padded)
    pstarts = pends - padded
    dest = pstarts[e_sorted] + (jnp.arange(A) - starts[e_sorted])
    n_rows = A + N_EXPERTS * EXPERT_BLOCK
    n_blocks = (n_rows + EXPERT_BLOCK - 1) // EXPERT_BLOCK
    n_rows = n_blocks * EXPERT_BLOCK
    row_tok = jnp.full((n_rows,), T, jnp.int32).at[dest].set(tok_sorted)
    row_w = jnp.zeros((n_rows,), jnp.float32).at[dest].set(w_sorted)
    block_expert = jnp.minimum(
        jnp.searchsorted(pends, jnp.arange(n_blocks) * EXPERT_BLOCK, side='right'), N_EXPERTS - 1)
    h_pad = jnp.concatenate([h, jnp.zeros((1, D), h.dtype)], axis=0)

    def expert_block(args):
        tok_b, e = args
        xb = h_pad[tok_b]
        gu = xb @ w_gate_up[e] + b_gate_up[e]
        gate = jnp.minimum(gu[:, :D_FF], SWIGLU_LIMIT)
        up = jnp.clip(gu[:, D_FF:], -SWIGLU_LIMIT, SWIGLU_LIMIT)
        act = (up + 1.0) * gate * jax.nn.sigmoid(SWIGLU_ALPHA * gate)
        return act @ w_down[e] + b_down[e]

    yb = lax.map(expert_block, (row_tok.reshape(n_blocks, EXPERT_BLOCK), block_expert))
    y = yb.reshape(n_rows, D) * row_w[:, None].astype(yb.dtype)
    return jax.ops.segment_sum(y, row_tok, num_segments=T + 1)[:T]


def hybrid_layer(x, positions, g_mix, w_in, g_q_latent, w_uq, g_kv_latent, w_ukv,
                 g_q_nope, g_q_rope, g_k_nope, g_k_rope, w_pool, s_pool, w_out,
                 g_ffn, w_router, b_router, w_gate_up, b_gate_up, w_down, b_down):
    B, S, D = x.shape
    h = rms_norm(x, g_mix)
    z = h @ w_in
    y_a = mla_branch(z[..., OFF_Q:OFF_KV], z[..., OFF_KV:OFF_KR], z[..., OFF_KR:OFF_POOL],
                     positions, g_q_latent, w_uq, g_kv_latent, w_ukv,
                     g_q_nope, g_q_rope, g_k_nope, g_k_rope)
    y_p = pool_branch(z[..., OFF_POOL:OFF_GA], w_pool, s_pool)
    merged = jax.nn.sigmoid(z[..., OFF_GA:OFF_GP]) * y_a + jax.nn.sigmoid(z[..., OFF_GP:]) * y_p
    x = x + merged @ w_out
    h2 = rms_norm(x, g_ffn).reshape(B * S, D)
    x = x + moe_ffn(h2, w_router, b_router, w_gate_up, b_gate_up, w_down, b_down).reshape(B, S, D)
    return x


def setup_inputs(seed: int = 0) -> dict:
    key = jax.random.key(seed)
    ks = jax.random.split(key, 24)
    f32 = jnp.float32

    def dense(k, shape, fan_in):
        return jax.random.normal(k, shape, f32) * (fan_in ** -0.5)

    def gain(k, n):
        return 1.0 + 0.1 * jax.random.normal(k, (n,), f32)

    def small(k, shape):
        return 0.01 * jax.random.normal(k, shape, f32)

    return {
        "x": jax.random.normal(ks[0], (BATCH, SEQ, D_MODEL), f32),
        "positions": jnp.broadcast_to(jnp.arange(SEQ, dtype=jnp.int32), (BATCH, SEQ)),
        "g_mix": gain(ks[1], D_MODEL),
        "w_in": dense(ks[2], (D_MODEL, IN_PROJ_WIDTH), D_MODEL),
        "g_q_latent": gain(ks[3], Q_LORA_RANK),
        "w_uq": dense(ks[4], (Q_LORA_RANK, N_HEADS * QK_HEAD_DIM), Q_LORA_RANK),
        "g_kv_latent": gain(ks[5], KV_LORA_RANK),
        "w_ukv": dense(ks[6], (KV_LORA_RANK, N_HEADS * (QK_NOPE_DIM + V_HEAD_DIM)), KV_LORA_RANK),
        "g_q_nope": gain(ks[7], QK_NOPE_DIM),
        "g_q_rope": gain(ks[8], QK_ROPE_DIM),
        "g_k_nope": gain(ks[9], QK_NOPE_DIM),
        "g_k_rope": gain(ks[10], QK_ROPE_DIM),
        "w_pool": dense(ks[11], (POOL_GROUPS, POOL_GROUP_DIM, POOL_OUT_GROUP_DIM), POOL_GROUP_DIM),
        "s_pool": gain(ks[12], D_MODEL),
        "w_out": dense(ks[13], (D_MODEL, D_MODEL), D_MODEL),
        "g_ffn": gain(ks[14], D_MODEL),
        "w_router": dense(ks[15], (D_MODEL, N_EXPERTS), D_MODEL),
        "b_router": small(ks[16], (N_EXPERTS,)),
        "w_gate_up": dense(ks[17], (N_EXPERTS, D_MODEL, 2 * D_FF), D_MODEL),
        "b_gate_up": small(ks[18], (N_EXPERTS, 2 * D_FF)),
        "w_down": dense(ks[19], (N_EXPERTS, D_FF, D_MODEL), D_FF),
        "b_down": small(ks[20], (N_EXPERTS, D_MODEL)),
    }


def reference(x, positions, g_mix, w_in, g_q_latent, w_uq, g_kv_latent, w_ukv,
              g_q_nope, g_q_rope, g_k_nope, g_k_rope, w_pool, s_pool, w_out,
              g_ffn, w_router, b_router, w_gate_up, b_gate_up, w_down, b_down):
    for _ in range(DEPTH):
        x = hybrid_layer(x, positions, g_mix, w_in, g_q_latent, w_uq, g_kv_latent, w_ukv,
                         g_q_nope, g_q_rope, g_k_nope, g_k_rope, w_pool, s_pool, w_out,
                         g_ffn, w_router, b_router, w_gate_up, b_gate_up, w_down, b_down)
    return x
```

```cpp
#include <hip/hip_runtime.h>
#include <cstdio>
#include <cstdint>

#ifndef MK_N_LAUNCHES
#define MK_N_LAUNCHES 1
#endif
#ifndef PROBE_PHASE
#define PROBE_PHASE -1
#endif

#define GAS __attribute__((address_space(1)))
#define LAS __attribute__((address_space(3)))
typedef unsigned short bf16_t;
typedef short bf16x8 __attribute__((ext_vector_type(8)));
typedef short s16x4 __attribute__((ext_vector_type(4)));
typedef float f32x2 __attribute__((ext_vector_type(2)));
typedef float f32x4 __attribute__((ext_vector_type(4)));
typedef float f32x16 __attribute__((ext_vector_type(16)));
typedef unsigned u32x2 __attribute__((ext_vector_type(2)));
typedef unsigned u32x4 __attribute__((ext_vector_type(4)));
typedef int i32x4 __attribute__((ext_vector_type(4)));
typedef int i32x8 __attribute__((ext_vector_type(8)));

constexpr int T = 16384, SEQ = 8192, DM = 2048, NH = 16;
constexpr int ZW = 6144;
constexpr int ZO_Q = 0, ZO_KV = 512, ZO_GA = 1024, ZO_GP = 3072, ZO_POOL = 5120;
constexpr int ZLD = 6272;
constexpr int NE = 32, TOPK = 4, DFF = 2048;
constexpr int XCAP = 16384;
constexpr int MT_MAX = 288, MP_MAX = MT_MAX * 256;
constexpr float RMS_EPS = 1e-6f;
constexpr float W8_SCALE = 64.0f, ACT8_SCALE = 4.0f, Y8_SCALE = 16.0f;
constexpr int NPH = 13;
constexpr int N_LAUNCHES = MK_N_LAUNCHES;

constexpr size_t MiB = 1u << 20;
constexpr size_t WS_CTL = 0, CTL_ZERO_BYTES = 1 * MiB;
constexpr size_t WS_WIN = 2 * MiB, WS_WUQ = 28 * MiB, WS_WUKV = 32 * MiB, WS_WPOOL = 36 * MiB, WS_WOUT = 38 * MiB, WS_WRT = 46 * MiB;
constexpr size_t WS_WKR = 47 * MiB;
constexpr size_t WS_ROUTE = 48 * MiB;
constexpr size_t WS_CS = 50 * MiB;
constexpr size_t WS_KPE = 54 * MiB, WS_NQ = 56 * MiB, WS_NKV = 72 * MiB, WS_POOLED = 88 * MiB, WS_H = 120 * MiB, WS_YP = 184 * MiB, WS_YA = 248 * MiB;
constexpr size_t WS_MERGED = 312 * MiB, WS_H2 = 376 * MiB, WS_Q = 440 * MiB, WS_KV = 536 * MiB, WS_Z = 664 * MiB, WS_WGU = 864 * MiB, WS_WD = 1376 * MiB;
constexpr size_t WS_XS = 1632 * MiB, WS_ACT = 1920 * MiB, WS_Y = 2208 * MiB, WS_X1 = 2496 * MiB;
constexpr size_t WS_H8 = 2624 * MiB, WS_WIN8 = 2656 * MiB, WS_ROWT = 2664 * MiB, WS_XSP = 2672 * MiB, WS_END = 3696 * MiB;
constexpr int CW_TMO = 0, CW_CODE = 1, CW_BAR = 4096, CW_CNT = 8192;

constexpr int RING_BYTES = 151552;
constexpr int MISC_OFF = RING_BYTES;
constexpr int LDS_BYTES = 155648;

#define RLX_AGENT __ATOMIC_RELAXED, __HIP_MEMORY_SCOPE_AGENT
#define LDS_WAIT() asm volatile("s_waitcnt lgkmcnt(0)" ::: "memory")
#define VM_WAIT() asm volatile("s_waitcnt vmcnt(0)" ::: "memory")

__device__ __forceinline__ unsigned cvt_pk_bf16(float lo, float hi) { unsigned r; asm volatile("v_cvt_pk_bf16_f32 %0, %1, %2" : "=v"(r) : "v"(lo), "v"(hi)); return r; }
__device__ __forceinline__ unsigned cvt_pk4_fp8(float a, float b, float c, float d) { int w; asm("" : "=v"(w));     w = __builtin_amdgcn_cvt_pk_fp8_f32(a, b, w, false); w = __builtin_amdgcn_cvt_pk_fp8_f32(c, d, w, true); return (unsigned)w; }
typedef short s16x2 __attribute__((ext_vector_type(2)));
__device__ __forceinline__ unsigned cvt_pk4_fp8_div(float a, float b, float c, float d, float sc) { int u; asm("" : "=v"(u)); s16x2 w = __builtin_bit_cast(s16x2, u);
    w = __builtin_amdgcn_cvt_scalef32_pk_fp8_f32(w, a, b, sc, false); w = __builtin_amdgcn_cvt_scalef32_pk_fp8_f32(w, c, d, sc, true); return (unsigned)__builtin_bit_cast(int, w); }
__device__ __forceinline__ float bf_lo(unsigned w) { return __uint_as_float(w << 16); }
__device__ __forceinline__ float bf_hi(unsigned w) { return __uint_as_float(w & 0xffff0000u); }
__device__ __forceinline__ float sigmoidf_(float x) { return __builtin_amdgcn_rcpf(1.0f + __builtin_amdgcn_exp2f(-1.4426950408889634f * x)); }
__device__ __forceinline__ int lane_id() { int l; asm volatile("v_mbcnt_lo_u32_b32 %0, -1, 0\n\tv_mbcnt_hi_u32_b32 %0, -1, %0" : "=v"(l)); return l; }
__device__ __forceinline__ float wave_sum(float v) {
#pragma unroll
    for (int o = 1; o < 64; o <<= 1) v += __shfl_xor(v, o);
    return v;
}

#define XB_TMO      128
#define XB_XCNT(j)  (256  + 64 * (j))
#define XB_XSUB(j)  (1280 + 64 * (j))
#define XB_XGEN(j)  (2304 + 64 * (j))
#define XB_TOP      3328
#define XB_TOPGEN   3392
#define XCD_BAR_WORDS 3456
#define XB_SPIN_CAP (1u << 22)
__device__ __forceinline__ unsigned xb_ld(unsigned* p)              { return __hip_atomic_load(p, __ATOMIC_RELAXED, __HIP_MEMORY_SCOPE_AGENT); }
__device__ __forceinline__ unsigned xb_add(unsigned* p, unsigned v) { return __hip_atomic_fetch_add(p, v, __ATOMIC_RELAXED, __HIP_MEMORY_SCOPE_AGENT); }
__device__ __forceinline__ unsigned xb_xcc_id() { return (unsigned)__builtin_amdgcn_s_getreg((3 << 11) | 20) & 0xFu; }
#define XB_SPIN(cond, bar) do { unsigned _sp = 0; while (cond) { __builtin_amdgcn_s_sleep(1); \
    if ((++_sp & 255u) == 0u) { if (xb_ld(&(bar)[XB_TMO])) break; if (_sp > XB_SPIN_CAP) { atomicAdd(&(bar)[XB_TMO], 1u); break; } } } } while (0)
struct XcdBarrier { unsigned* bar; unsigned x; volatile LAS unsigned* st; };
__device__ __forceinline__ XcdBarrier xcd_barrier_post(unsigned* bar, volatile LAS unsigned* st, bool leader) {
    XcdBarrier b; b.bar = bar; b.x = xb_xcc_id(); b.st = st;
    if (leader) (void)xb_add(&bar[XB_XCNT(b.x)], 1u);
    return b;
}
__device__ __forceinline__ void xcd_barrier_complete(unsigned* bar, unsigned x, unsigned& nloc, unsigned& nx) {
    const unsigned G = gridDim.x * gridDim.y * gridDim.z;
    unsigned sum, cnt, mine, sp = 0u;
    for (;;) {
        sum = 0u; cnt = 0u; mine = 0u;
#pragma unroll
        for (unsigned j = 0; j < 16; ++j) { const unsigned c = xb_ld(&bar[XB_XCNT(j)]); sum += c; cnt += (c > 0u) ? 1u : 0u; mine = (j == x) ? c : mine; }
        if (sum == G) break;
        __builtin_amdgcn_s_sleep(1);
        if ((++sp & 255u) == 0u) { if (xb_ld(&bar[XB_TMO])) break; if (sp > XB_SPIN_CAP) { atomicAdd(&bar[XB_TMO], 1u); break; } }
    }
    nloc = mine > 0u ? mine : 1u; nx = cnt > 0u ? cnt : 1u;
}
__device__ __forceinline__ void xcd_barrier(const XcdBarrier& b, bool leader) {
    asm volatile("s_waitcnt vmcnt(0)" ::: "memory");
    __syncthreads();
    if (leader) {
        unsigned* bar = b.bar;
        __builtin_amdgcn_s_waitcnt(0);
        unsigned nloc = b.st[0], nx = b.st[1];
        if (nloc == 0u) { xcd_barrier_complete(bar, b.x, nloc, nx); b.st[0] = nloc; b.st[1] = nx; }
        const unsigned old = xb_add(&bar[XB_XSUB(b.x)], 1u);
        const unsigned gen = old / nloc;
        if (old + 1u == (gen + 1u) * nloc) {
            __builtin_amdgcn_fence(__ATOMIC_RELEASE, "agent");
            asm volatile("s_waitcnt vmcnt(0)" ::: "memory");
            const unsigned og = xb_add(&bar[XB_TOP], 1u);
            const unsigned tg = og / nx;
            if (og + 1u == (tg + 1u) * nx) xb_add(&bar[XB_TOPGEN], 1u);
            else XB_SPIN(xb_ld(&bar[XB_TOPGEN]) == tg, bar);
            __builtin_amdgcn_fence(__ATOMIC_ACQUIRE, "agent");
            xb_add(&bar[XB_XGEN(b.x)], 1u);
            asm volatile("s_waitcnt vmcnt(0)" ::: "memory");
        } else {
            XB_SPIN(xb_ld(&bar[XB_XGEN(b.x)]) == gen, bar);
            __builtin_amdgcn_fence(__ATOMIC_ACQUIRE, "agent");
            asm volatile("s_waitcnt vmcnt(0)" ::: "memory");
        }
    }
    __syncthreads();
}

namespace pg8 {
constexpr int BM = 256, BK = 64, HALF = 128, HTB = HALF * BK * 2, STAGE_BYTES = 8 * HTB, NXCD = 8, WGM = 8;
__host__ __device__ __forceinline__ int lds_byte(int r, int c) { const int st = (r >> 4) * 2 + (c >> 5), rr = r & 15, cc = c & 31, ob = rr * 64 + cc * 2; return st * 1024 + (ob ^ (((ob >> 9) & 1) << 5)); }
__host__ __device__ __forceinline__ void stage_rc(int b, int& R, int& C) { const int st = b / 1024, sb = b % 1024, swz = sb ^ (((sb >> 9) & 1) << 5); R = (st >> 1) * 16 + swz / 64; C = (st & 1) * 32 + (swz % 64) / 2; }
__host__ __device__ __forceinline__ int perm32(int rho) { const int n = rho >> 4, i = rho & 15; return 8 * (i >> 2) + 4 * n + (i & 3); }

struct Unit { int pm, pn, e, lr0; const char* A; const char* B; };
__device__ __forceinline__ int xcd_chunk(int L, int nwg) { const int q = nwg / NXCD, r = nwg % NXCD, xcd = L % NXCD, off = L / NXCD; return (xcd < r ? xcd * (q + 1) : r * (q + 1) + (xcd - r) * q) + off; }

struct DenseOrder {
    const char* A; const char* Bt; int lda, ldb; int nM, nN, nwg, G, c;
    __device__ __forceinline__ void init(const bf16_t* A_, int lda_, const bf16_t* Bt_, int ldb_, int M, int N, int G_, int c_) { A = (const char*)A_; Bt = (const char*)Bt_; lda = lda_; ldb = ldb_; nM = M / BM; nN = N / BM; nwg = nM * nN; G = G_; c = c_; }
    __device__ __forceinline__ bool next(int i, Unit& u) const {
        const int L = i * G + c; if (L >= nwg) return false;
        const int wgid = xcd_chunk(L, nwg);
        const int nig = WGM * nN, gid = wgid / nig, fm = gid * WGM, gsz = (nM - fm) < WGM ? (nM - fm) : WGM;
        u.pm = fm + ((wgid % nig) % gsz); u.pn = (wgid % nig) / gsz; u.e = 0; u.lr0 = 0;
        u.A = A + (size_t)u.pm * BM * lda * 2; u.B = Bt + (size_t)u.pn * BM * ldb * 2; return true;
    }
};
struct PoolOrder : DenseOrder {
    __device__ __forceinline__ bool next(int i, Unit& u) const {
        if (!DenseOrder::next(i, u)) return false;
        u.A += (size_t)(u.pn >> 1) * 256 * 2; return true;
    }
};
struct MoeOrder {
    const char* A; const char* Bt; size_t estride; const LAS int* ts; int nN, nwg, G, c, rowb, slabA;
    __device__ __forceinline__ void init(const void* A_, int slabA_, const void* Bt_, size_t estride_bytes, int rowbytes, const LAS int* ts_, int nN_, int G_, int c_) { slabA = slabA_; A = (const char*)A_; Bt = (const char*)Bt_; estride = estride_bytes; rowb = rowbytes; ts = ts_; nN = nN_; nwg = __builtin_amdgcn_readfirstlane(ts_[NE]) * nN_; G = G_; c = c_; }
    __device__ __forceinline__ bool next(int i, Unit& u) const {
        const int L = i * G + c; if (L >= nwg) return false;
        const int wgid = xcd_chunk(L, nwg);
        const int lj = lane_id() & 31;
        const unsigned long long bal = __ballot(ts[lj] * nN <= wgid);
        const int e = __builtin_popcount((unsigned)bal) - 1;
        const int t0 = __builtin_amdgcn_readfirstlane(ts[e]), mt = __builtin_amdgcn_readfirstlane(ts[e + 1]) - t0, uu = wgid - t0 * nN;
        const int lt = uu % mt; u.pm = t0 + lt; u.pn = uu / mt; u.e = e; u.lr0 = lt * BM;
        u.A = A + (slabA ? ((size_t)e * XCAP + (size_t)lt * BM) : (size_t)u.pm * BM) * rowb; u.B = Bt + (size_t)e * estride + (size_t)u.pn * BM * rowb; return true;
    }
};

struct EpiBf16 {
    static constexpr bool PERM = true; static constexpr bool PERMA = false;
    bf16_t* O; int ldc; float sc;
    __device__ __forceinline__ void operator()(const f32x4 (&acc)[2][2][4][2], const Unit& u, int wr, int wc, int fr, int fq) const {
        const int row0 = u.pm * BM + wr * 64 + fr, col0 = u.pn * BM + wc * 32 + 8 * fq;
#pragma unroll
        for (int ai = 0; ai < 2; ++ai)
#pragma unroll
            for (int m = 0; m < 4; ++m) { bf16_t* rowp = O + (size_t)(row0 + ai * HALF + m * 16) * ldc + col0;
#pragma unroll
                for (int bj = 0; bj < 2; ++bj) { const f32x4 v0 = acc[ai][bj][m][0] * sc, v1 = acc[ai][bj][m][1] * sc;
                    u32x4 w; w.x = cvt_pk_bf16(v0[0], v0[1]); w.y = cvt_pk_bf16(v0[2], v0[3]); w.z = cvt_pk_bf16(v1[0], v1[1]); w.w = cvt_pk_bf16(v1[2], v1[3]);
                    *(u32x4*)(rowp + bj * HALF) = w; } }
    }
};
struct EpiZ {
    static constexpr bool PERM = true; static constexpr bool PERMA = false;
    bf16_t* O; int ldc; float sc; unsigned char* Z8;
    __device__ __forceinline__ void operator()(const f32x4 (&acc)[2][2][4][2], const Unit& u, int wr, int wc, int fr, int fq) const {
        const int row0 = u.pm * BM + wr * 64 + fr, col0 = u.pn * BM + wc * 32 + 8 * fq;
        const bool lat = u.pn < 4;
#pragma unroll
        for (int ai = 0; ai < 2; ++ai)
#pragma unroll
            for (int m = 0; m < 4; ++m) { const size_t r = (size_t)(row0 + ai * HALF + m * 16); bf16_t* rowp = O + r * ldc + col0;
#pragma unroll
                for (int bj = 0; bj < 2; ++bj) { const f32x4 v0 = acc[ai][bj][m][0] * sc, v1 = acc[ai][bj][m][1] * sc;
                    u32x4 w; w.x = cvt_pk_bf16(v0[0], v0[1]); w.y = cvt_pk_bf16(v0[2], v0[3]); w.z = cvt_pk_bf16(v1[0], v1[1]); w.w = cvt_pk_bf16(v1[2], v1[3]);
                    *(u32x4*)(rowp + bj * HALF) = w;
                    if (lat) { u32x2 z; z.x = cvt_pk4_fp8(v0[0], v0[1], v0[2], v0[3]); z.y = cvt_pk4_fp8(v1[0], v1[1], v1[2], v1[3]); *(u32x2*)(Z8 + r * 1024 + col0 + bj * HALF) = z; } } }
    }
};
struct EpiRowScale {
    static constexpr bool PERM = true; static constexpr bool PERMA = false;
    bf16_t* O; int ldc; const float* rs;
    __device__ __forceinline__ void operator()(const f32x4 (&acc)[2][2][4][2], const Unit& u, int wr, int wc, int fr, int fq) const {
        const int row0 = u.pm * BM + wr * 64 + fr, col0 = u.pn * BM + wc * 32 + 8 * fq;
#pragma unroll
        for (int ai = 0; ai < 2; ++ai)
#pragma unroll
            for (int m = 0; m < 4; ++m) { const int r = row0 + ai * HALF + m * 16; const float c = rs[r] * (1.0f / W8_SCALE);     bf16_t* rowp = O + (size_t)r * ldc + col0;
#pragma unroll
                for (int bj = 0; bj < 2; ++bj) { const f32x4 v0 = acc[ai][bj][m][0] * c, v1 = acc[ai][bj][m][1] * c;
                    u32x4 w; w.x = cvt_pk_bf16(v0[0], v0[1]); w.y = cvt_pk_bf16(v0[2], v0[3]); w.z = cvt_pk_bf16(v1[0], v1[1]); w.w = cvt_pk_bf16(v1[2], v1[3]);
                    *(u32x4*)(rowp + bj * HALF) = w; } }
    }
};
constexpr float KSC_ = 1.4426950408889634f * 0.07216878364870322f / 0.25f;
struct EpiKV {
    static constexpr bool PERM = true; static constexpr bool PERMA = true;
    unsigned char* K8; unsigned char* V8T; const float* rs; const float* gk; const float* gq; LAS float* xch;
    __device__ __forceinline__ void operator()(const f32x4 (&acc)[2][2][4][2], const Unit& u, int wr, int wc, int fr, int fq) const {
        const int rl0 = wr * 64 + 4 * fr, dl0 = wc * 32 + 8 * fq;
#pragma unroll
        for (int ai = 0; ai < 2; ++ai)
#pragma unroll
            for (int m = 0; m < 4; ++m) { const int rl = rl0 + ai * HALF + m; const float c = rs[u.pm * BM + rl] * (1.0f / W8_SCALE);
                const f32x4 a = acc[ai][0][m][0] * c, b = acc[ai][0][m][1] * c;
                float q = (a[0] * a[0] + a[1] * a[1]) + (a[2] * a[2] + a[3] * a[3]) + (b[0] * b[0] + b[1] * b[1]) + (b[2] * b[2] + b[3] * b[3]);
                q += __shfl_xor(q, 16); q += __shfl_xor(q, 32);
                if (fq == 0) xch[rl * 4 + wc] = q; }
        asm volatile("s_waitcnt lgkmcnt(0)" ::: "memory"); __builtin_amdgcn_s_barrier(); asm volatile("" ::: "memory");
        const f32x4 g0 = *(const f32x4*)(gk + dl0) * *(const f32x4*)(gq + dl0), g1 = *(const f32x4*)(gk + dl0 + 4) * *(const f32x4*)(gq + dl0 + 4);
        const int kpos = 64 * (wc >> 1) + 32 * (fq & 1) + 8 * ((2 * wc + (fq >> 1)) & 3);
#pragma unroll
        for (int ai = 0; ai < 2; ++ai)
#pragma unroll
            for (int m = 0; m < 4; ++m) { const int rl = rl0 + ai * HALF + m; const float c = rs[u.pm * BM + rl] * (1.0f / W8_SCALE);
                const f32x4 pq = *(const LAS f32x4*)(xch + rl * 4); const float rstd = rsqrtf(((pq[0] + pq[1]) + (pq[2] + pq[3])) * (1.0f / 128.0f) + RMS_EPS) * c;
                const f32x4 v0 = acc[ai][0][m][0] * (rstd * KSC_) * g0, v1 = acc[ai][0][m][1] * (rstd * KSC_) * g1;
                u32x2 w; w.x = cvt_pk4_fp8(v0[0], v0[1], v0[2], v0[3]); w.y = cvt_pk4_fp8(v1[0], v1[1], v1[2], v1[3]);
                *(u32x2*)(K8 + (size_t)(u.pm * BM + rl) * 2048 + u.pn * 128 + kpos) = w; }
        const int t0 = u.pm * BM, bb = t0 / SEQ, tile0 = (t0 % SEQ) / 64 + wr;
#pragma unroll
        for (int ai = 0; ai < 2; ++ai) { unsigned char* tb = V8T + ((size_t)((bb * NH + u.pn) * (SEQ / 64) + tile0 + 2 * ai)) * 8192 + 4 * ((fr >> 1) & 3);
            const f32x4 c4 = *(const f32x4*)(rs + u.pm * BM + rl0 + ai * HALF) * (1.0f / W8_SCALE);
#pragma unroll
            for (int e = 0; e < 8; ++e) { const int D = dl0 + e, ch = 2 * (fr & 1) + (fr >> 3);
                const unsigned w = cvt_pk4_fp8(acc[ai][1][0][e >> 2][e & 3] * c4[0], acc[ai][1][1][e >> 2][e & 3] * c4[1], acc[ai][1][2][e >> 2][e & 3] * c4[2], acc[ai][1][3][e >> 2][e & 3] * c4[3]);
                *(unsigned*)(tb + D * 64 + (((ch ^ (D >> 2)) & 3) << 4)) = w; } }
        asm volatile("s_waitcnt lgkmcnt(0)" ::: "memory"); __builtin_amdgcn_s_barrier(); asm volatile("" ::: "memory");
    }
};
struct EpiPool {
    static constexpr bool PERM = true; static constexpr bool PERMA = false;
    bf16_t* O; const bf16_t* Z; const bf16_t* YA; const float* s_pool;
    __device__ __forceinline__ void operator()(const f32x4 (&acc)[2][2][4][2], const Unit& u, int wr, int wc, int fr, int fq) const {
        const int row0 = u.pm * BM + wr * 64 + fr, col0 = u.pn * BM + wc * 32 + 8 * fq;
        f32x4 sv[2][2];
#pragma unroll
        for (int bj = 0; bj < 2; ++bj)
#pragma unroll
            for (int n = 0; n < 2; ++n) sv[bj][n] = *(const f32x4*)(s_pool + col0 + bj * HALF + 4 * n);
#pragma unroll
        for (int ai = 0; ai < 2; ++ai)
#pragma unroll
            for (int m = 0; m < 4; ++m) { const size_t r = (size_t)(row0 + ai * HALF + m * 16); bf16_t* rowp = O + r * DM + col0; const bf16_t* zr = Z + r * ZLD + col0; const bf16_t* yr = YA + r * DM + col0;
#pragma unroll
                for (int bj = 0; bj < 2; ++bj) { const u32x4 g = *(const u32x4*)(zr + ZO_GP + bj * HALF), a = *(const u32x4*)(zr + ZO_GA + bj * HALF), y = *(const u32x4*)(yr + bj * HALF);
                    const f32x4 v0 = acc[ai][bj][m][0] * sv[bj][0], v1 = acc[ai][bj][m][1] * sv[bj][1];
                    u32x4 w;
                    w.x = cvt_pk_bf16(v0[0] * sigmoidf_(bf_lo(g.x)) + sigmoidf_(bf_lo(a.x)) * bf_lo(y.x), v0[1] * sigmoidf_(bf_hi(g.x)) + sigmoidf_(bf_hi(a.x)) * bf_hi(y.x));
                    w.y = cvt_pk_bf16(v0[2] * sigmoidf_(bf_lo(g.y)) + sigmoidf_(bf_lo(a.y)) * bf_lo(y.y), v0[3] * sigmoidf_(bf_hi(g.y)) + sigmoidf_(bf_hi(a.y)) * bf_hi(y.y));
                    w.z = cvt_pk_bf16(v1[0] * sigmoidf_(bf_lo(g.z)) + sigmoidf_(bf_lo(a.z)) * bf_lo(y.z), v1[1] * sigmoidf_(bf_hi(g.z)) + sigmoidf_(bf_hi(a.z)) * bf_hi(y.z));
                    w.w = cvt_pk_bf16(v1[2] * sigmoidf_(bf_lo(g.w)) + sigmoidf_(bf_lo(a.w)) * bf_lo(y.w), v1[3] * sigmoidf_(bf_hi(g.w)) + sigmoidf_(bf_hi(a.w)) * bf_hi(y.w));
                    *(u32x4*)(rowp + bj * HALF) = w; } }
    }
};
struct EpiOut {
    static constexpr bool PERM = true; static constexpr bool PERMA = false;
    const float* base; bf16_t* C; unsigned char* H2; const float* g;
    __device__ __forceinline__ void operator()(const f32x4 (&acc)[2][2][4][2], const Unit& u, int wr, int wc, int fr, int fq) const {
        const int row0 = u.pm * BM + wr * 64 + fr, col0 = u.pn * BM + wc * 32 + 8 * fq;
        f32x4 gv[2][2];
#pragma unroll
        for (int bj = 0; bj < 2; ++bj)
#pragma unroll
            for (int n = 0; n < 2; ++n) gv[bj][n] = *(const f32x4*)(g + col0 + bj * HALF + 4 * n);
#pragma unroll
        for (int ai = 0; ai < 2; ++ai)
#pragma unroll
            for (int m = 0; m < 4; ++m) { const size_t off = (size_t)(row0 + ai * HALF + m * 16) * DM + col0;
#pragma unroll
                for (int bj = 0; bj < 2; ++bj) { const f32x4 v0 = *(const f32x4*)(base + off + bj * HALF) + acc[ai][bj][m][0], v1 = *(const f32x4*)(base + off + bj * HALF + 4) + acc[ai][bj][m][1];
                    { u32x4 xw; xw.x = cvt_pk_bf16(v0[0], v0[1]); xw.y = cvt_pk_bf16(v0[2], v0[3]); xw.z = cvt_pk_bf16(v1[0], v1[1]); xw.w = cvt_pk_bf16(v1[2], v1[3]); *(u32x4*)(C + off + bj * HALF) = xw; }
                    const f32x4 h0 = v0 * gv[bj][0], h1 = v1 * gv[bj][1];
                    u32x2 w; w.x = cvt_pk4_fp8(h0[0], h0[1], h0[2], h0[3]); w.y = cvt_pk4_fp8(h1[0], h1[1], h1[2], h1[3]);
                    *(u32x2*)(H2 + off + bj * HALF) = w; } }
    }
};
struct EpiSwiglu {
    static constexpr bool PERM = true; static constexpr bool PERMA = false;
    unsigned char* O; const float* bgu; const float* rs;
    __device__ __forceinline__ void operator()(const f32x4 (&acc)[2][2][4][2], const Unit& u, int wr, int wc, int fr, int fq) const {
        const int row0 = u.pm * BM + wr * 64 + fr, j0 = u.pn * HALF + wc * 32 + 8 * fq;
        const float* bg = bgu + (size_t)u.e * 2 * DFF + j0;
        f32x4 bgv[2], buv[2];
#pragma unroll
        for (int n = 0; n < 2; ++n) { bgv[n] = *(const f32x4*)(bg + 4 * n); buv[n] = *(const f32x4*)(bg + DFF + 4 * n); }
        constexpr float inv = 1.0f / W8_SCALE;
#pragma unroll
        for (int ai = 0; ai < 2; ++ai)
#pragma unroll
            for (int m = 0; m < 4; ++m) { const int r = row0 + ai * HALF + m * 16; unsigned char* rowp = O + (size_t)r * DFF + j0; const float sc = inv * rs[(size_t)u.e * XCAP + u.lr0 + (r - u.pm * BM)];
                float a[8];
#pragma unroll
                for (int n = 0; n < 2; ++n)
#pragma unroll
                    for (int h = 0; h < 2; ++h) {
                        const f32x2 ag = {acc[ai][0][m][n][2 * h], acc[ai][0][m][n][2 * h + 1]}, au = {acc[ai][1][m][n][2 * h], acc[ai][1][m][n][2 * h + 1]};
                        const f32x2 bg2 = {bgv[n][2 * h], bgv[n][2 * h + 1]}, bu2 = {buv[n][2 * h], buv[n][2 * h + 1]};
                        f32x2 g = ag * sc + bg2, up = au * sc + bu2;
                        g.x = fminf(g.x, 7.0f); g.y = fminf(g.y, 7.0f);
                        up.x = __builtin_amdgcn_fmed3f(up.x, -7.0f, 7.0f); up.y = __builtin_amdgcn_fmed3f(up.y, -7.0f, 7.0f);
                        const f32x2 t = g * (-1.702f * 1.4426950408889634f);
                        f32x2 e; e.x = __builtin_amdgcn_exp2f(t.x); e.y = __builtin_amdgcn_exp2f(t.y);
                        const f32x2 d = e + 1.0f;
                        f32x2 rr; rr.x = __builtin_amdgcn_rcpf(d.x); rr.y = __builtin_amdgcn_rcpf(d.y);
                        const f32x2 o2 = (up * ACT8_SCALE + ACT8_SCALE) * (g * rr);
                        a[4 * n + 2 * h] = o2.x; a[4 * n + 2 * h + 1] = o2.y; }
                u32x2 w; w.x = cvt_pk4_fp8(a[0], a[1], a[2], a[3]); w.y = cvt_pk4_fp8(a[4], a[5], a[6], a[7]);
                *(u32x2*)rowp = w; }
    }
};
struct EpiDown {
    static constexpr bool PERM = true; static constexpr bool PERMA = false;
    unsigned char* O; const float* bd; const float* row_w;
    __device__ __forceinline__ void operator()(const f32x4 (&acc)[2][2][4][2], const Unit& u, int wr, int wc, int fr, int fq) const {
        const int row0 = u.pm * BM + wr * 64 + fr, col0 = u.pn * BM + wc * 32 + 8 * fq;
        const float* b = bd + (size_t)u.e * DM + col0;
        f32x4 bv[2][2];
#pragma unroll
        for (int bj = 0; bj < 2; ++bj)
#pragma unroll
            for (int n = 0; n < 2; ++n) bv[bj][n] = *(const f32x4*)(b + bj * HALF + 4 * n);
#pragma unroll
        for (int ai = 0; ai < 2; ++ai)
#pragma unroll
            for (int m = 0; m < 4; ++m) { const int r = row0 + ai * HALF + m * 16; const float rw = row_w[(size_t)u.e * XCAP + u.lr0 + (r - u.pm * BM)] * Y8_SCALE; unsigned char* rowp = O + (size_t)r * DM + col0;
#pragma unroll
                for (int bj = 0; bj < 2; ++bj) { const f32x4 v0 = (acc[ai][bj][m][0] * (1.0f / (W8_SCALE * ACT8_SCALE)) + bv[bj][0]) * rw, v1 = (acc[ai][bj][m][1] * (1.0f / (W8_SCALE * ACT8_SCALE)) + bv[bj][1]) * rw;
                    u32x2 w; w.x = cvt_pk4_fp8(v0[0], v0[1], v0[2], v0[3]); w.y = cvt_pk4_fp8(v1[0], v1[1], v1[2], v1[3]);
                    *(u32x2*)(rowp + bj * HALF) = w; } }
    }
};

template <bool FP8 = false, class Epi, class Sched>
__device__ __forceinline__ void gemm_phase(LAS unsigned char* lds, const int K, const int lda, const int ldb, const Sched& S, const Epi& E, const int wid) {
    const int lane = lane_id(), tid = wid * 64 + lane, wr = wid >> 2, wc = wid & 3, fr = lane & 15, fq = lane >> 4;
    const int nt = K / BK;
    unsigned voffA[2], voffB[2];
#pragma unroll
    for (int i = 0; i < 2; ++i) { int R, C; stage_rc(tid * 16 + i * 8192, R, C); const int Rb = Epi::PERM ? ((R & ~31) + perm32(R & 31)) : R;
        const int Ra = Epi::PERMA ? ((R & ~63) + 4 * (R & 15) + ((R >> 4) & 3)) : R;
        voffA[i] = (unsigned)(Ra * lda + C) * 2u; voffB[i] = (unsigned)(Rb * ldb + C) * 2u; }
    const size_t kstep = (size_t)(BK * 2);
    const size_t hstepA = (size_t)HALF * lda * 2, hstepB = (size_t)HALF * ldb * 2;
    const unsigned ldsb = (unsigned)(uintptr_t)lds + (unsigned)wid * 1024u;
    const int aoff = lds_byte(wr * 64 + fr, fq * 8), boff = lds_byte(wc * 32 + fr, fq * 8);
#define PG8_SA(b, h) (((b) * 2 + (h)) * HTB)
#define PG8_SB(b, h) ((4 + (b) * 2 + (h)) * HTB)
#define PG8_STAGE(bufoff, gbase, voff) do { _Pragma("unroll") for (int _i = 0; _i < 2; ++_i) { unsigned keep_; \
        asm volatile("s_mov_b32 %0, m0\n\ts_mov_b32 m0, %3\n\ts_nop 0\n\tglobal_load_lds_dwordx4 %1, %2\n\ts_mov_b32 m0, %0" : "=&s"(keep_) : "v"((voff)[_i]), "s"(gbase), "s"(ldsb + (unsigned)((bufoff) + _i * 8192)) : "memory"); } } while (0)
#define PG8_LD8(addr) __builtin_shufflevector(*(const LAS i32x4*)(addr), *(const LAS i32x4*)((addr) + 1024), 0, 1, 2, 3, 4, 5, 6, 7)
#define PG8_LDA(dst, b, h) do { _Pragma("unroll") for (int m = 0; m < 4; ++m) dst[m] = PG8_LD8(lds + PG8_SA(b, h) + aoff + m * 2048); } while (0)
#define PG8_LDB(dst, b, h) do { _Pragma("unroll") for (int n = 0; n < 2; ++n) dst[n] = PG8_LD8(lds + PG8_SB(b, h) + boff + n * 2048); } while (0)
#define PG8_LO(x) __builtin_bit_cast(bf16x8, __builtin_shufflevector((x), (x), 0, 1, 2, 3))
#define PG8_HI(x) __builtin_bit_cast(bf16x8, __builtin_shufflevector((x), (x), 4, 5, 6, 7))
#define PG8_MMA(ai, bj, At, Bt) do { __builtin_amdgcn_s_setprio(1); _Pragma("unroll") for (int m = 0; m < 4; ++m) _Pragma("unroll") for (int n = 0; n < 2; ++n) { \
        if constexpr (FP8) acc[ai][bj][m][n] = __builtin_amdgcn_mfma_scale_f32_16x16x128_f8f6f4(Bt[n], At[m], acc[ai][bj][m][n], 0, 0, 0, 0, 0, 0); \
        else { acc[ai][bj][m][n] = __builtin_amdgcn_mfma_f32_16x16x32_bf16(PG8_LO(Bt[n]), PG8_LO(At[m]), acc[ai][bj][m][n], 0, 0, 0); \
               acc[ai][bj][m][n] = __builtin_amdgcn_mfma_f32_16x16x32_bf16(PG8_HI(Bt[n]), PG8_HI(At[m]), acc[ai][bj][m][n], 0, 0, 0); } } \
        __builtin_amdgcn_s_setprio(0); } while (0)
#define PG8_WAIT_V(n) asm volatile("s_waitcnt vmcnt(" #n ")" ::: "memory")
#define PG8_WAIT_L(n) asm volatile("s_waitcnt lgkmcnt(" #n ")" ::: "memory")
#define PG8_BAR __builtin_amdgcn_s_barrier()
#define PG8_SCHED __builtin_amdgcn_sched_barrier(0)
    Unit cur, nxt; int ui = 0;
    if (!S.next(0, cur)) return;
    f32x4 acc[2][2][4][2];
#pragma unroll
    for (int a = 0; a < 2; ++a)
#pragma unroll
        for (int b = 0; b < 2; ++b)
#pragma unroll
            for (int m = 0; m < 4; ++m)
#pragma unroll
                for (int n = 0; n < 2; ++n) acc[a][b][m][n] = (f32x4){0.f, 0.f, 0.f, 0.f};
    i32x8 At[4], B0[2], B1[2];
    const char* cA = cur.A; const char* cB = cur.B;
    PG8_STAGE(PG8_SB(0, 0), cB, voffB); PG8_STAGE(PG8_SB(0, 1), cB + hstepB, voffB); PG8_STAGE(PG8_SA(0, 0), cA, voffA); PG8_STAGE(PG8_SA(0, 1), cA + hstepA, voffA);
    if (wr == 1) PG8_BAR;
    PG8_WAIT_V(2); PG8_BAR;
    PG8_STAGE(PG8_SB(1, 0), cB + kstep, voffB); PG8_STAGE(PG8_SA(1, 0), cA + kstep, voffA); PG8_STAGE(PG8_SB(1, 1), cB + hstepB + kstep, voffB);
    PG8_WAIT_V(6); PG8_BAR;
    for (;;) {
        const bool has_next = S.next(ui + 1, nxt);
        const char* nA = has_next ? nxt.A : cA; const char* nB = has_next ? nxt.B : cB;
#pragma unroll 1
        for (int t = 0; t < nt; t += 2) {
            const bool last = (t == nt - 2);
            const char* a1 = cA + (size_t)(t + 1) * kstep;
            const char* a2 = last ? nA : cA + (size_t)(t + 2) * kstep; const char* b2 = last ? nB : cB + (size_t)(t + 2) * kstep;
            const char* a3 = a2 + kstep; const char* b3 = b2 + kstep;
            PG8_LDB(B0, 0, 0); PG8_LDB(B1, 0, 1); PG8_SCHED; PG8_LDA(At, 0, 0); PG8_STAGE(PG8_SA(1, 1), a1 + hstepA, voffA);
            PG8_WAIT_V(8); PG8_WAIT_L(0); PG8_BAR; PG8_MMA(0, 0, At, B0); PG8_MMA(0, 1, At, B1); PG8_BAR; PG8_SCHED;
            PG8_LDA(At, 0, 1); PG8_STAGE(PG8_SB(0, 0), b2, voffB); PG8_STAGE(PG8_SB(0, 1), b2 + hstepB, voffB); PG8_STAGE(PG8_SA(0, 0), a2, voffA);
            PG8_WAIT_V(8); PG8_WAIT_L(0); PG8_BAR; PG8_MMA(1, 0, At, B0); PG8_MMA(1, 1, At, B1); PG8_BAR; PG8_SCHED;
            PG8_LDB(B0, 1, 0); PG8_LDB(B1, 1, 1); PG8_SCHED; PG8_LDA(At, 1, 0); PG8_STAGE(PG8_SA(0, 1), a2 + hstepA, voffA);
            PG8_WAIT_V(8); PG8_WAIT_L(0); PG8_BAR; PG8_MMA(0, 0, At, B0); PG8_MMA(0, 1, At, B1); PG8_BAR; PG8_SCHED;
            PG8_LDA(At, 1, 1); PG8_STAGE(PG8_SB(1, 0), b3, voffB); PG8_STAGE(PG8_SB(1, 1), b3 + hstepB, voffB); PG8_STAGE(PG8_SA(1, 0), a3, voffA);
            PG8_WAIT_V(8); PG8_WAIT_L(0); PG8_BAR; PG8_MMA(1, 0, At, B0); PG8_MMA(1, 1, At, B1); PG8_BAR; PG8_SCHED;
        }
        if (wr == 0) PG8_BAR;
        { const int l2 = lane_id(); E(acc, cur, wr, wc, l2 & 15, l2 >> 4); }
        if (!has_next) break;
#pragma unroll
        for (int a = 0; a < 2; ++a)
#pragma unroll
            for (int b = 0; b < 2; ++b)
#pragma unroll
                for (int m = 0; m < 4; ++m)
#pragma unroll
                    for (int n = 0; n < 2; ++n) acc[a][b][m][n] = (f32x4){0.f, 0.f, 0.f, 0.f};
        cur = nxt; cA = nA; cB = nB; ++ui;
        if (wr == 1) PG8_BAR;
    }
    PG8_WAIT_V(0);
    PG8_BAR;
#undef PG8_SA
#undef PG8_SB
#undef PG8_STAGE
#undef PG8_LDA
#undef PG8_LDB
#undef PG8_MMA
#undef PG8_LO
#undef PG8_HI
#undef PG8_LD8
#undef PG8_WAIT_V
#undef PG8_WAIT_L
#undef PG8_BAR
#undef PG8_SCHED
}
}

namespace att {
constexpr int NW = 8, QBLK = 32, KVBLK = 64, QB = NW * QBLK;
constexpr int QS = 3072, K8S = 2048, KP8S = 64, OS = 2048;
constexpr int STG = 20480, NSTG = 6, SOFF_K = 0, SOFF_V = 12288;
constexpr int OFF_WS = NSTG * STG;
constexpr int LDS_BYTES = OFF_WS + NW * 64 * 4;
constexpr float SCALE = 0.07216878364870322f;
constexpr float QSC = 0.25f, KSC = 1.4426950408889634f * SCALE / QSC;
constexpr float THR = 3.f, PLOG2 = 4.f;
#ifndef ATT_NQR
#define ATT_NQR 4
#endif
constexpr int NQR = ATT_NQR;
constexpr int WBIG = 0x40000000;
static_assert(LDS_BYTES <= RING_BYTES, "attention LDS");

#define K8SW(key, c) ((key) * 64 + ((((c) ^ ((key) >> 2)) & 3) << 4))
#define SBAR() __builtin_amdgcn_sched_barrier(0)
__device__ __forceinline__ int crow(int r, int hi) { return (r & 3) + 8 * (r >> 2) + 4 * hi; }
__device__ __forceinline__ bf16x8 load8(const bf16_t* p) { return *reinterpret_cast<const bf16x8*>(p); }
__device__ __forceinline__ void mask_tile(f32x16& p0, f32x16& p1, int dq, unsigned W) {
    const float NEG = -__builtin_inff();
#pragma unroll
    for (int r = 0; r < 16; ++r) {
        const int c = (r & 3) + 8 * (r >> 2);
        if ((unsigned)(dq - c) >= W) p0[r] = NEG;
        if ((unsigned)(dq - c - 32) >= W) p1[r] = NEG;
    }
}
template <bool FIRST>
__device__ __forceinline__ bool partialSM(f32x16& p0, f32x16& p1, float& M, float& sc, float& alpha) {
    float tmax = p0[0]; for (int r = 1; r < 16; ++r) tmax = fmaxf(tmax, p0[r]); for (int r = 0; r < 16; ++r) tmax = fmaxf(tmax, p1[r]);
    { auto rr = __builtin_amdgcn_permlane32_swap(__float_as_uint(tmax), __float_as_uint(tmax), false, false);
      tmax = fmaxf(__uint_as_float(rr[0]), __uint_as_float(rr[1])); }
    const bool moved = FIRST || !__all(tmax - M <= THR * 1.4426950408889634f);
    if (__builtin_expect(moved, FIRST)) {
        const float Mn = FIRST ? ceilf(tmax) : fmaxf(M, ceilf(tmax));
        alpha = __builtin_amdgcn_exp2f(M - Mn); M = Mn; sc = __builtin_amdgcn_exp2f(Mn - PLOG2);
    } else alpha = 1.f;
    for (int r = 0; r < 16; ++r) p0[r] = __builtin_amdgcn_exp2f(p0[r]);
    return moved;
}
__device__ __forceinline__ void finishSM(f32x16& p0, f32x16& p1, float sc, i32x8& pa) {
    for (int r = 0; r < 16; ++r) p1[r] = __builtin_amdgcn_exp2f(p1[r]);
#pragma unroll
    for (int v = 0; v < 4; ++v) { pa[v] = (int)cvt_pk4_fp8_div(p0[4 * v], p0[4 * v + 1], p0[4 * v + 2], p0[4 * v + 3], sc); pa[4 + v] = (int)cvt_pk4_fp8_div(p1[4 * v], p1[4 * v + 1], p1[4 * v + 2], p1[4 * v + 3], sc); }
}
__device__ __forceinline__ void qkt(f32x16& p0, f32x16& p1, const char* stg, int ka, const i32x8* qf) {
    p0 = f32x16{}; p1 = f32x16{};
#pragma unroll
    for (int s = 0; s < 3; ++s) { const char* a = stg + SOFF_K + s * 4096 + ka; const char* b = stg + SOFF_K + s * 4096 + (ka ^ 16);
        const i32x4 a0 = *reinterpret_cast<const i32x4*>(a), a1 = *reinterpret_cast<const i32x4*>(b);
        const i32x4 c0 = *reinterpret_cast<const i32x4*>(a + 2048), c1 = *reinterpret_cast<const i32x4*>(b + 2048);
        p0 = __builtin_amdgcn_mfma_scale_f32_32x32x64_f8f6f4(__builtin_shufflevector(a0, a1, 0, 1, 2, 3, 4, 5, 6, 7), qf[s], p0, 0, 0, 0, 0, 0, 0);
        p1 = __builtin_amdgcn_mfma_scale_f32_32x32x64_f8f6f4(__builtin_shufflevector(c0, c1, 0, 1, 2, 3, 4, 5, 6, 7), qf[s], p1, 0, 0, 0, 0, 0, 0); }
}
__device__ __forceinline__ void v_read(i32x8 (&vf)[4], const char* stg, int ka) {
#pragma unroll
    for (int d0 = 0; d0 < 4; ++d0) { const i32x4 a0 = *reinterpret_cast<const i32x4*>(stg + SOFF_V + d0 * 2048 + ka), a1 = *reinterpret_cast<const i32x4*>(stg + SOFF_V + d0 * 2048 + (ka ^ 16));
        vf[d0] = __builtin_shufflevector(a0, a1, 0, 1, 2, 3, 4, 5, 6, 7); }
}
__device__ __forceinline__ void pv_mma(f32x16* o, f32x16& ol, const i32x8 (&vf)[4], const i32x8 ones, const i32x8 pa) {
#pragma unroll
    for (int d0 = 0; d0 < 4; ++d0) o[d0] = __builtin_amdgcn_mfma_scale_f32_32x32x64_f8f6f4(pa, vf[d0], o[d0], 0, 0, 0, 0, 0, 0);
    ol = __builtin_amdgcn_mfma_scale_f32_32x32x64_f8f6f4(pa, ones, ol, 0, 0, 0, 0, 0, 0);
}
struct BlockRef { const bf16_t* Q; const unsigned char* V8; const unsigned char* K8; const unsigned char* KP; bf16_t* O; int P0, tok0; };
struct Seam { bf16x8 qr[NQR]; int g; };
typedef const GAS char* gptr;
__device__ __forceinline__ gptr uni(const GAS void* p) { const unsigned long long v = (unsigned long long)p; const unsigned lo = __builtin_amdgcn_readfirstlane((unsigned)v), hi = __builtin_amdgcn_readfirstlane((unsigned)(v >> 32)); return (gptr)(((unsigned long long)hi << 32) | lo); }
__device__ __forceinline__ bf16x8 ldu(gptr ubase, unsigned voff) { return *reinterpret_cast<const GAS bf16x8*>(ubase + voff); }
#define VMW() asm volatile("s_waitcnt vmcnt(0)" ::: "memory")
#define VMWN(n) asm volatile("s_waitcnt vmcnt(%0)" :: "i"(n) : "memory")
#define ATT_DMA(ldsaddr, gbase, voff) do { unsigned keep_; asm volatile("s_mov_b32 %0, m0\n\ts_mov_b32 m0, %3\n\ts_nop 0\n\tglobal_load_lds_dwordx4 %1, %2\n\ts_mov_b32 m0, %0" : "=&s"(keep_) : "v"(voff), "s"(gbase), "s"(ldsaddr) : "memory"); } while (0)
#define DMA_SETUP() const unsigned ldsw = (unsigned)__builtin_amdgcn_readfirstlane((int)(unsigned)(uintptr_t)lds) + (unsigned)wid * 1024u;                                              \
    const unsigned voff_v8 = (unsigned)tid * 16u, voff_kn = (unsigned)(((tid >> 2) & 63) * K8S + (tid >> 8) * 64 + (((tid & 3) ^ (tid >> 4)) & 3) * 16),                                  \
                   voff_kp = (unsigned)(((tid >> 2) & 63) * KP8S + (((tid & 3) ^ (tid >> 4)) & 3) * 16)
#define DMA_TILE(st, v8b, k8b, kpb) do { const unsigned sb_ = ldsw + (unsigned)(st) * (unsigned)STG; ATT_DMA(sb_ + SOFF_K, (k8b), voff_kn); ATT_DMA(sb_ + SOFF_V, (v8b), voff_v8);   \
        if (wid < 4) ATT_DMA(sb_ + SOFF_K + 8192, (kpb), voff_kp); } while (0)
#define DMA_WAIT1() do { if (wid < 4) VMWN(3); else VMWN(2); } while (0)
#define QLOAD(ref) do { gptr qb_ = uni((const GAS void*)((ref).Q + (size_t)(wid * QBLK) * QS)); _Pragma("unroll") for (int d0 = 0; d0 < NQR; ++d0) S.qr[d0] = ldu(qb_ + d0 * 32, voff_q); } while (0)
#define QPLOAD(ref) do { gptr qb_ = uni((const GAS void*)((ref).Q + (size_t)(wid * QBLK) * QS)); _Pragma("unroll") for (int d0 = NQR; d0 < 12; ++d0) q12[d0] = ldu(qb_ + d0 * 32, voff_q); } while (0)
struct QNorm { const float* CS; const float* gqn; const float* gqr; };
__device__ __forceinline__ void unpk8(bf16x8 x, float (&v)[8]) { const u32x4 w = __builtin_bit_cast(u32x4, x);
    v[0] = bf_lo(w.x); v[1] = bf_hi(w.x); v[2] = bf_lo(w.y); v[3] = bf_hi(w.y); v[4] = bf_lo(w.z); v[5] = bf_hi(w.z); v[6] = bf_lo(w.w); v[7] = bf_hi(w.w); }
__device__ __forceinline__ bf16x8 pk8(const float (&v)[8]) { u32x4 w; w.x = cvt_pk_bf16(v[0], v[1]); w.y = cvt_pk_bf16(v[2], v[3]); w.z = cvt_pk_bf16(v[4], v[5]); w.w = cvt_pk_bf16(v[6], v[7]); return __builtin_bit_cast(bf16x8, w); }
struct QCoef { f32x4 c[4], s[4], ga[4], gb[4]; };
__device__ __forceinline__ void qcoef_load(QCoef& C, const QNorm& N, int tok, int hi) {
#pragma unroll
    for (int f = 0; f < 2; ++f) { const int i0 = f * 16 + hi * 8; const float* cp = N.CS + (size_t)tok * 64 + i0; const float* g = N.gqr + i0;
#pragma unroll
        for (int j = 0; j < 2; ++j) { C.c[2 * f + j] = *(const f32x4*)(cp + 4 * j); C.s[2 * f + j] = *(const f32x4*)(cp + 32 + 4 * j); C.ga[2 * f + j] = *(const f32x4*)(g + 4 * j); C.gb[2 * f + j] = *(const f32x4*)(g + 32 + 4 * j); } }
}
__device__ __forceinline__ void qnorm_rope(const bf16x8 (&q)[12], const QCoef& C, i32x8 (&qf)[3]) {
    float sn = 0.f, sp = 0.f, v[8];
#pragma unroll
    for (int f = 0; f < 8; ++f) { unpk8(q[f], v);
#pragma unroll
        for (int e = 0; e < 8; ++e) sn += v[e] * v[e]; }
#pragma unroll
    for (int f = 8; f < 12; ++f) { unpk8(q[f], v);
#pragma unroll
        for (int e = 0; e < 8; ++e) sp += v[e] * v[e]; }
    { auto rr = __builtin_amdgcn_permlane32_swap(__float_as_uint(sn), __float_as_uint(sn), false, false); sn = __uint_as_float(rr[0]) + __uint_as_float(rr[1]); }
    { auto rr = __builtin_amdgcn_permlane32_swap(__float_as_uint(sp), __float_as_uint(sp), false, false); sp = __uint_as_float(rr[0]) + __uint_as_float(rr[1]); }
    const float rn = rsqrtf(sn * (1.f / 128.f) + RMS_EPS), rp = rsqrtf(sp * (1.f / 64.f) + RMS_EPS);
#pragma unroll
    for (int f = 0; f < 8; ++f) { unpk8(q[f], v);
#pragma unroll
        for (int e = 0; e < 8; ++e) v[e] *= rn * QSC;
        qf[f >> 2][2 * (f & 3)] = (int)cvt_pk4_fp8(v[0], v[1], v[2], v[3]); qf[f >> 2][2 * (f & 3) + 1] = (int)cvt_pk4_fp8(v[4], v[5], v[6], v[7]); }
#pragma unroll
    for (int f = 0; f < 2; ++f) {
        float t1[8], t2[8], o1[8], o2[8]; unpk8(q[8 + f], t1); unpk8(q[10 + f], t2);
#pragma unroll
        for (int e = 0; e < 8; ++e) { const int j = 2 * f + (e >> 2), k = e & 3; const float a = t1[e] * (rp * QSC) * C.ga[j][k], b = t2[e] * (rp * QSC) * C.gb[j][k]; o1[e] = a * C.c[j][k] - b * C.s[j][k]; o2[e] = b * C.c[j][k] + a * C.s[j][k]; }
        qf[2][2 * f] = (int)cvt_pk4_fp8(o1[0], o1[1], o1[2], o1[3]); qf[2][2 * f + 1] = (int)cvt_pk4_fp8(o1[4], o1[5], o1[6], o1[7]);
        qf[2][4 + 2 * f] = (int)cvt_pk4_fp8(o2[0], o2[1], o2[2], o2[3]); qf[2][5 + 2 * f] = (int)cvt_pk4_fp8(o2[4], o2[5], o2[6], o2[7]); }
}
__device__ __forceinline__ void prime(const BlockRef& cur, char* lds, Seam& S, const int wid) {
    const int lane = lane_id(), tid = wid * 64 + lane, r32 = lane & 31, hi = lane >> 5;
    DMA_SETUP();
    const unsigned voff_q = (unsigned)(r32 * QS + hi * 8) * 2u;
    QLOAD(cur);
    gptr V8h = uni((const GAS void*)cur.V8); gptr K8h = uni((const GAS void*)cur.K8); gptr KPh = uni((const GAS void*)cur.KP);
    DMA_TILE(0, V8h, K8h, KPh); DMA_TILE(1, V8h + 8192, K8h + KVBLK * K8S, KPh + KVBLK * KP8S);
    S.g = 0;
}
template <int AV>
__device__ __forceinline__ void block(const BlockRef& cur, const BlockRef& nxt, char* lds, Seam& S, const int wid, const QNorm& QN) {
    const int lane = lane_id(), tid = wid * 64 + lane, r32 = lane & 31, hi = lane >> 5;
    const int NT = (cur.P0 + QB - 1) / KVBLK + 1;
    const int qlo = cur.P0 + wid * QBLK, qm = qlo + r32 - 4 * hi;
    float* ws = (float*)(lds + OFF_WS) + wid * 64; float* al_l = ws + 32;
    float m_reg = 0.f, sc8 = 1.f; f32x16 o[4] = {}, ol = {};
    i32x8 ones;
#pragma unroll
    for (int i = 0; i < 8; ++i) ones[i] = 0x38383838;
    asm volatile("" : "+v"(ones));
    DMA_SETUP();
    const unsigned voff_q = (unsigned)(r32 * QS + hi * 8) * 2u;
    const int ka = K8SW(r32, 2 * hi);
    const int g = __builtin_amdgcn_readfirstlane(S.g);
    gptr V8h = uni((const GAS void*)cur.V8); gptr K8h = uni((const GAS void*)cur.K8); gptr KPh = uni((const GAS void*)cur.KP);
    gptr nV8h = uni((const GAS void*)nxt.V8); gptr nK8h = uni((const GAS void*)nxt.K8); gptr nKPh = uni((const GAS void*)nxt.KP);
#define RESC(a) do { { if (hi == 0) al_l[r32] = (a); asm volatile("s_waitcnt lgkmcnt(0)" ::: "memory");                                  \
                     for (int d_ = 0; d_ < 4; ++d_) for (int r = 0; r < 16; ++r) o[d_][r] *= al_l[crow(r, hi)];                           \
                     for (int r = 0; r < 16; ++r) ol[r] *= al_l[crow(r, hi)]; } } while (0)
#define KBASE(t) ((t) * KVBLK)
#define INC6(x, k) (((x) + (k)) >= NSTG ? ((x) + (k) - NSTG) : ((x) + (k)))
#define STGP(st) (lds + (st) * STG)
#define ISSUE(tn, stn) do { const int tn_ = (tn); const bool in_ = tn_ < NT; const int tt_ = in_ ? tn_ : tn_ - NT;                                               \
        DMA_TILE((stn), uni((in_ ? V8h : nV8h) + (size_t)tt_ * 8192), uni((in_ ? K8h : nK8h) + (size_t)tt_ * (KVBLK * K8S)), uni((in_ ? KPh : nKPh) + (size_t)tt_ * (KVBLK * KP8S))); } while (0)
#define MASKT(P0_, P1_, t) do { const int kb_ = KBASE(t); if (kb_ + KVBLK - 1 > qlo) mask_tile(P0_, P1_, qm - kb_, (unsigned)WBIG); } while (0)
    f32x16 pA0, pA1, pB0, pB1; float mnA, mnB, alA, alB; i32x8 pa, vf[4];
    bf16x8 q12[12]; QPLOAD(cur); QCoef qc_; qcoef_load(qc_, QN, cur.tok0 + wid * QBLK + r32, hi); SBAR();
    VMW(); __syncthreads();
    if (!(AV & 8)) { ISSUE(2, INC6(g, 2)); ISSUE(3, INC6(g, 3)); }
    { _Pragma("unroll") for (int d0 = 0; d0 < NQR; ++d0) q12[d0] = S.qr[d0]; }
    i32x8 qf[3];
    qnorm_rope(q12, qc_, qf);
    SBAR(); qkt(pA0, pA1, STGP(g), ka, qf);
    MASKT(pA0, pA1, 0); (void)partialSM<true>(pA0, pA1, m_reg, sc8, alA);
#define STEP(PX0, PX1, mnX, alX, PY0, PY1, alY, t, stx, stv) do {                                                             \
        SBAR();                                                                                                               \
        if (!(AV & 2)) qkt(PX0, PX1, STGP(stx), ka, qf); else { _Pragma("unroll") for (int r_ = 0; r_ < 16; ++r_) { PX0[r_] = __int_as_float(qf[0][r_ & 7]) + PX0[r_]; PX1[r_] = __int_as_float(qf[1][r_ & 7]) + PX1[r_]; } } \
        if (!(AV & 1)) finishSM(PY0, PY1, sc8, pa); else { _Pragma("unroll") for (int v_ = 0; v_ < 8; ++v_) pa[v_] = __float_as_int(PY0[v_]) ^ __float_as_int(PY1[v_ + 8]); }  SBAR();   \
        if (!(AV & 2)) { v_read(vf, STGP(stv), ka); pv_mma(o, ol, vf, ones, pa); } else { _Pragma("unroll") for (int r_ = 0; r_ < 16; ++r_) { o[0][r_] += __int_as_float(pa[r_ & 7]); ol[r_] += 1.f; } }                \
        if (!(AV & 1)) { MASKT(PX0, PX1, (t)); if (partialSM<false>(PX0, PX1, m_reg, sc8, alX)) RESC(alX); } } while (0)
    int sc = INC6(g, 1);
    if (wid < 4) __builtin_amdgcn_s_setprio(1);
    STEP(pB0, pB1, mnB, alB, pA0, pA1, alA, 1, sc, g);
    for (int t = 2; t < NT; t += 2) {
        const int sp = sc, s0 = INC6(sc, 1), s1 = INC6(sc, 2), s2 = INC6(sc, 3), s3 = INC6(sc, 4);
        VMW(); if (!(AV & 4)) __syncthreads(); if (!(AV & 8)) { ISSUE(t + 2, s2); ISSUE(t + 3, s3); }
        STEP(pA0, pA1, mnA, alA, pB0, pB1, alB, t, s0, sp);
        STEP(pB0, pB1, mnB, alB, pA0, pA1, alA, t + 1, s1, s0);
        sc = s1;
    }
    SBAR(); QLOAD(nxt); v_read(vf, STGP(sc), ka); SBAR();
    finishSM(pB0, pB1, sc8, pa); SBAR();
    pv_mma(o, ol, vf, ones, pa);
    S.g = INC6(sc, 1);
    __builtin_amdgcn_s_setprio(0);
    float rli[16];
#pragma unroll
    for (int r = 0; r < 16; ++r) rli[r] = __builtin_amdgcn_rcpf(ol[r]);
    GAS char* Ow = (GAS char*)uni((const GAS void*)(cur.O + (size_t)(wid * QBLK) * OS));
    const bool odd = (r32 & 1) != 0;
    const unsigned voff_o = (unsigned)((4 * hi + (odd ? 1 : 0)) * OS + (r32 & ~1)) * 2u;
#pragma unroll
    for (int r = 0; r < 16; r += 2) { const int orow0 = (r & 3) + 8 * (r >> 2);
#pragma unroll
        for (int d0 = 0; d0 < 4; ++d0) { const float a = o[d0][r] * rli[r], b = o[d0][r + 1] * rli[r + 1];
            const float send = odd ? a : b;
            const float recv = __int_as_float(__builtin_amdgcn_mov_dpp(__float_as_int(send), 0xB1, 0xF, 0xF, true));
            *(GAS unsigned*)(Ow + (size_t)orow0 * OS * 2 + d0 * 64 + voff_o) = cvt_pk_bf16(odd ? recv : a, odd ? b : recv); } }
    __syncthreads();
#undef RESC
#undef KBASE
#undef STGP
#undef INC6
#undef ISSUE
#undef MASKT
#undef STEP
}
#undef QLOAD
#undef QPLOAD
#undef QPWRITE
constexpr int NQB = SEQ / QB, NX = NQB / 2, NITEMS = 2 * NH * NX;
struct Item { int bh, qb0, qb1; };
__device__ __forceinline__ Item decode(int L) {
    const int xcd = L & 7, k = L >> 3; Item it; it.bh = (k / NX) * 8 + xcd; const int x = k % NX; it.qb0 = x; it.qb1 = NQB - 1 - x; return it;
}
__device__ __forceinline__ BlockRef mkref(const Item& it, int pass, const bf16_t* Q, const unsigned char* V8T, const unsigned char* K8, const unsigned char* KPE, bf16_t* O) {
    const int qb = pass ? it.qb1 : it.qb0, b = it.bh / NH, h = it.bh % NH;
    BlockRef r; const size_t t0 = (size_t)b * SEQ;
    r.Q = Q + (t0 + (size_t)qb * QB) * QS + h * 192; r.O = O + (t0 + (size_t)qb * QB) * OS + h * 128;
    r.V8 = V8T + (size_t)it.bh * (SEQ / 64) * 8192; r.K8 = K8 + t0 * K8S + h * 128; r.KP = KPE + t0 * KP8S; r.P0 = qb * QB; r.tok0 = (int)t0 + qb * QB;
    return r;
}
template <int PSEL, int AV = 0>
__device__ __forceinline__ void attn_phase(char* lds, const bf16_t* Q, const unsigned char* KV, const unsigned char* K8, const unsigned char* KPE, bf16_t* O, int G, int c, const int wid, const QNorm& QN) {
    int L = c; if (L >= NITEMS) return;
    Item it = decode(L); int pass = PSEL < 0 ? 0 : PSEL;
    BlockRef cur = mkref(it, pass, Q, KV, K8, KPE, O);
    Seam S;
    prime(cur, lds, S, wid);
    for (;;) {
        const bool more_pass = PSEL < 0 && pass == 0, more_item = L + G < NITEMS, last = !more_pass && !more_item;
        Item itn = it; int passn = pass + 1, Ln = L;
        if (!more_pass) { passn = PSEL < 0 ? 0 : PSEL; Ln = more_item ? L + G : L; itn = decode(Ln); }
        const BlockRef nxt = last ? cur : mkref(itn, passn, Q, KV, K8, KPE, O);
        block<AV>(cur, nxt, lds, S, wid, QN);
        if (last) break;
        cur = nxt; it = itn; pass = passn; L = Ln;
    }
    VMW(); __syncthreads();
}
#undef VMW
#undef VMWN
#undef ATT_DMA
#undef DMA_SETUP
#undef DMA_TILE
#undef DMA_WAIT1
}

struct Params { const float* in[22]; float* out; unsigned char* ws; int ph_lo, ph_hi; };
enum { I_X = 0, I_POS, I_GMIX, I_WIN, I_GQL, I_WUQ, I_GKVL, I_WUKV, I_GQN, I_GQR, I_GKN, I_GKR, I_WPOOL, I_SPOOL, I_WOUT, I_GFFN, I_WR, I_BR, I_WGU, I_BGU, I_WD, I_BD };

__device__ __forceinline__ void transpose_item(const float* W, int N, int k0, int n0, bf16_t* WT, int ldk, int dst_row0, LAS float* scr, int lane, const float* kgain) {
    float v[32];
#pragma unroll
    for (int i = 0; i < 32; ++i) v[i] = W[(size_t)(k0 + 2 * i + (lane >> 5)) * N + n0 + (lane & 31)];
    if (kgain) {
#pragma unroll
        for (int i = 0; i < 32; ++i) v[i] *= kgain[k0 + 2 * i + (lane >> 5)]; }
#pragma unroll
    for (int i = 0; i < 32; ++i) { const int kk = 2 * i + (lane >> 5); scr[kk * 32 + ((lane & 31) ^ ((kk >> 3) << 2))] = v[i]; }
    LDS_WAIT(); asm volatile("" ::: "memory");
    const int c = lane & 7;
#pragma unroll
    for (int j = 0; j < 4; ++j) { const int n = (lane >> 3) + 8 * j; const LAS float* s = scr + (8 * c) * 32 + (n ^ (c << 2));
        u32x4 o; o.x = cvt_pk_bf16(s[0 * 32], s[1 * 32]); o.y = cvt_pk_bf16(s[2 * 32], s[3 * 32]); o.z = cvt_pk_bf16(s[4 * 32], s[5 * 32]); o.w = cvt_pk_bf16(s[6 * 32], s[7 * 32]);
        *(u32x4*)(WT + (size_t)(dst_row0 + n) * ldk + k0 + 8 * c) = o; }
    LDS_WAIT(); asm volatile("" ::: "memory");
}

__device__ __forceinline__ void transpose_item_fp8(const float* W, int N, int k0, int n0, unsigned char* WT, int ldk, int dst_row0, LAS float* scr, int lane, const float* kgain) {
    float v[64];
#pragma unroll
    for (int i = 0; i < 64; ++i) v[i] = W[(size_t)(k0 + 2 * i + (lane >> 5)) * N + n0 + (lane & 31)];
#pragma unroll
    for (int i = 0; i < 64; ++i) { const int kk = 2 * i + (lane >> 5); scr[kk * 32 + ((lane & 31) ^ ((kk >> 4) << 2))] = v[i] * W8_SCALE; }
    LDS_WAIT(); asm volatile("" ::: "memory");
    const int c = lane & 7;
    f32x4 g[4];
#pragma unroll
    for (int q = 0; q < 4; ++q) g[q] = kgain ? *(const f32x4*)(kgain + k0 + 16 * c + 4 * q) : (f32x4){1.f, 1.f, 1.f, 1.f};
#pragma unroll
    for (int j = 0; j < 4; ++j) { const int n = (lane >> 3) + 8 * j; const LAS float* s = scr + (16 * c) * 32 + (n ^ (c << 2));
        u32x4 o; o.x = cvt_pk4_fp8(s[0 * 32] * g[0][0], s[1 * 32] * g[0][1], s[2 * 32] * g[0][2], s[3 * 32] * g[0][3]); o.y = cvt_pk4_fp8(s[4 * 32] * g[1][0], s[5 * 32] * g[1][1], s[6 * 32] * g[1][2], s[7 * 32] * g[1][3]);
        o.z = cvt_pk4_fp8(s[8 * 32] * g[2][0], s[9 * 32] * g[2][1], s[10 * 32] * g[2][2], s[11 * 32] * g[2][3]); o.w = cvt_pk4_fp8(s[12 * 32] * g[3][0], s[13 * 32] * g[3][1], s[14 * 32] * g[3][2], s[15 * 32] * g[3][3]);
        *(u32x4*)(WT + (size_t)(dst_row0 + n) * ldk + k0 + 16 * c) = o; }
    LDS_WAIT(); asm volatile("" ::: "memory");
}

typedef const GAS char* cgptr;
__device__ __forceinline__ cgptr cuni(const void* p) { const unsigned long long v = (unsigned long long)p; const unsigned lo = __builtin_amdgcn_readfirstlane((unsigned)v), hi = __builtin_amdgcn_readfirstlane((unsigned)(v >> 32)); return (cgptr)(((unsigned long long)hi << 32) | lo); }
struct ConvItem { cgptr src; cgptr dstp; unsigned N4; };
__device__ __forceinline__ ConvItem conv_decode(int it, const float* wgu, const float* wd, unsigned char* WguT, unsigned char* WdT) {
    constexpr int I_GU = NE * 16 * 128;
    ConvItem c; int r = it, nbn, N; const float* src; unsigned char* dstp; bool gu;
    if (r < I_GU) { const int e = r / (16 * 128); r -= e * (16 * 128); N = 4096; nbn = 128; src = wgu + (size_t)e * DM * 4096; dstp = WguT + (size_t)e * 4096 * DM; gu = true; }
    else { r -= I_GU; const int e = r / (16 * 64); r -= e * (16 * 64); N = DM; nbn = 64; src = wd + (size_t)e * DFF * DM; dstp = WdT + (size_t)e * DM * DFF; gu = false; }
    const int kb = r / nbn, nb = r - kb * nbn, n0 = nb * 32, k0 = kb * 128; int dst = n0;
    if (gu) { const int j = n0 & 2047; dst = (j >> 7) * 256 + (j & 127) + ((n0 >= 2048) ? 128 : 0); }
    c.src = cuni(src + (size_t)k0 * N + n0); c.dstp = cuni(dstp + (size_t)dst * DM + k0); c.N4 = (unsigned)N * 4u;
    return c;
}
#define CONV_LOAD(v, c) do { const unsigned lo_ = (unsigned)(lane >> 3) * (c).N4 + 16u * (unsigned)(lane & 7); _Pragma("unroll") for (int i = 0; i < 16; ++i) v[i] = __builtin_nontemporal_load((const GAS f32x4*)(cuni((const void*)((c).src + (size_t)(8 * i) * (c).N4)) + lo_)); } while (0)
#define CONV_STORE(v, c) do { _Pragma("unroll") for (int i = 0; i < 16; ++i) { const int kk_ = 8 * i + (lane >> 3); *(LAS f32x4*)(scr + kk_ * 32 + ((4 * (lane & 7)) ^ ((kk_ >> 4) << 2))) = v[i] * W8_SCALE; }     \
        LDS_WAIT(); asm volatile("" ::: "memory"); const int ch_ = lane & 7; const unsigned so_ = (unsigned)(lane >> 3) * (unsigned)DM + 16u * (unsigned)ch_;                          \
        _Pragma("unroll") for (int j = 0; j < 4; ++j) { const int n = (lane >> 3) + 8 * j; const LAS float* s_ = scr + (16 * ch_) * 32 + (n ^ (ch_ << 2));                       \
            u32x4 o; o.x = cvt_pk4_fp8(s_[0 * 32], s_[1 * 32], s_[2 * 32], s_[3 * 32]); o.y = cvt_pk4_fp8(s_[4 * 32], s_[5 * 32], s_[6 * 32], s_[7 * 32]);                     \
            o.z = cvt_pk4_fp8(s_[8 * 32], s_[9 * 32], s_[10 * 32], s_[11 * 32]); o.w = cvt_pk4_fp8(s_[12 * 32], s_[13 * 32], s_[14 * 32], s_[15 * 32]);                       \
            __builtin_nontemporal_store(o, (GAS u32x4*)((GAS char*)cuni((const void*)((c).dstp + (size_t)(8 * j) * DM)) + so_)); }                                                                    \
        LDS_WAIT(); asm volatile("" ::: "memory"); } while (0)
__device__ __forceinline__ void convert_expert_weights(const float* wgu, const float* wd, unsigned char* WguT, unsigned char* WdT, LAS float* scr, int gw, int NGW, int lane) {
    constexpr int NIT = NE * 16 * 128 + NE * 16 * 64;
    int it = gw; if (it >= NIT) return;
    f32x4 va[16], vb[16];
    ConvItem ca = conv_decode(it, wgu, wd, WguT, WdT), cb = ca;
    CONV_LOAD(va, ca);
    for (;;) {
        const bool hb = it + NGW < NIT; cb = conv_decode(hb ? it + NGW : it, wgu, wd, WguT, WdT); CONV_LOAD(vb, cb);
        CONV_STORE(va, ca);
        if (!hb) break;
        it += NGW;
        const bool ha = it + NGW < NIT; ca = conv_decode(ha ? it + NGW : it, wgu, wd, WguT, WdT); CONV_LOAD(va, ca);
        CONV_STORE(vb, cb);
        if (!ha) break;
        it += NGW;
    }
}
#undef CONV_LOAD
#undef CONV_STORE

__device__ __forceinline__ void moe_tables(const unsigned* cnt, LAS int* ts, const int tid) {
    if (tid < NE) ts[64 + tid] = (int)__hip_atomic_load(cnt + tid, RLX_AGENT);
    __syncthreads();
    if (tid == 0) { int acc = 0;
        for (int e = 0; e < NE; ++e) { ts[e] = acc; acc += (ts[64 + e] + 255) >> 8; }
        ts[NE] = acc < MT_MAX ? acc : MT_MAX; }
    __syncthreads();
}

__global__ void __launch_bounds__(512, 2) fwd_kernel(Params p) {
    extern __shared__ __attribute__((aligned(16))) unsigned char lds_raw[];
    LAS unsigned char* lds = (LAS unsigned char*)lds_raw;
    volatile LAS unsigned* MISC = (volatile LAS unsigned*)(lds + MISC_OFF);
    const int wave = __builtin_amdgcn_readfirstlane((int)threadIdx.x >> 6);
#define LANE_TID() const int lane = lane_id(), tid = wave * 64 + lane
    const int G = gridDim.x, bx = blockIdx.x;
    const int vcu = (G % 8 == 0) ? (bx % 8) * (G / 8) + bx / 8 : bx;
    unsigned char* ws = p.ws;
    unsigned* ctl = (unsigned*)(ws + WS_CTL);
    { LANE_TID(); for (int u = tid; u < 1024; u += 512) MISC[u] = 0u; }
    __syncthreads();
    XcdBarrier bar; bar.bar = ctl + CW_BAR; bar.x = 0; bar.st = nullptr;
    if (N_LAUNCHES == 1) bar = xcd_barrier_post(ctl + CW_BAR, MISC + 8, wave == 0 && lane_id() == 0);
#define GRID_BAR() do { if (N_LAUNCHES == 1) xcd_barrier(bar, wave == 0 && lane_id() == 0); } while (0)
    const int lo = (N_LAUNCHES == 1 && PROBE_PHASE < 0) ? 0 : p.ph_lo, hi = (N_LAUNCHES == 1 && PROBE_PHASE < 0) ? NPH : p.ph_hi;
#define IN(k) (lo <= (k) && (k) < hi)
#define BOTH(k) (IN(k) && IN((k) + 1))
    const int gw = vcu * 8 + wave, NGW = G * 8, NGT = G * 512;
#define GT() (vcu * 512 + tid)

    bf16_t* WinT = (bf16_t*)(ws + WS_WIN + 16 * MiB); bf16_t* WuqT = (bf16_t*)(ws + WS_WUQ); bf16_t* WukvT = (bf16_t*)(ws + WS_WUKV); bf16_t* WpoolT = (bf16_t*)(ws + WS_WPOOL);
    bf16_t* WoutT = (bf16_t*)(ws + WS_WOUT); float* WrT = (float*)(ws + WS_WRT); unsigned char* WguT = ws + WS_WGU; unsigned char* WdT = ws + WS_WD;
    bf16_t* Hb = (bf16_t*)(ws + WS_H); bf16_t* Zb = (bf16_t*)(ws + WS_Z); bf16_t* NQ = (bf16_t*)(ws + WS_NQ); bf16_t* NKV = (bf16_t*)(ws + WS_NKV);
    unsigned char* KPE8 = ws + WS_KPE; unsigned char* K8b = ws + WS_NQ; unsigned char* V8T = ws + WS_KV; unsigned char* Z8 = ws + WS_KV + 64 * MiB;
    bf16_t* POOLED = (bf16_t*)(ws + WS_POOLED); bf16_t* Qb = (bf16_t*)(ws + WS_Q); bf16_t* KVb = (bf16_t*)(ws + WS_KV);
    bf16_t* YP = (bf16_t*)(ws + WS_YP); bf16_t* YA = (bf16_t*)(ws + WS_YA); bf16_t* MERGED = (bf16_t*)(ws + WS_MERGED); unsigned char* H2 = ws + WS_H2;
    unsigned char* H8 = ws + WS_H8; unsigned char* Win8 = ws + WS_WIN; unsigned char* XS = ws + WS_XSP; unsigned char* ACT = ws + WS_ACT; unsigned char* Yb = ws + WS_Y;
    int* tok_e = (int*)(ws + WS_ROUTE); float* tok_w = (float*)(ws + WS_ROUTE + 256 * 1024); int* tok_rank = (int*)(ws + WS_ROUTE + 512 * 1024); int* tok_pos = (int*)(ws + WS_ROUTE + 768 * 1024);
    float* row_w = (float*)(ws + WS_ROWT); float* CS = (float*)(ws + WS_CS);
    float* RSQ = (float*)(ws + WS_ROUTE + 1536 * 1024); float* RSKV = (float*)(ws + WS_ROUTE + 1600 * 1024);
    float* RS2 = (float*)(ws + WS_ROUTE + 1664 * 1024); float* row_rs = (float*)(ws + WS_ROWT + 2 * MiB);
    bf16_t* X1 = (bf16_t*)(ws + WS_X1);

    if (IN(0)) { LANE_TID();
        LAS float* scr = (LAS float*)(lds + wave * 16896);
        constexpr int I_IN = 32 * 34, I_IN8 = 16 * 160, I_UQ = 4 * 96, I_UKV = 4 * 128, I_PL = 4 * 4 * 16, I_OUT = 32 * 64;
        constexpr int NITEMS = I_IN + I_IN8 + I_UQ + I_UKV + I_PL + I_OUT;
        for (int it = gw; it < NITEMS; it += NGW) {
            int r = it, idx, N, nbn, ldk; size_t soff = 0, doff; bool f8 = false;
            if (r < I_IN) { idx = I_WIN; N = 6208; nbn = 34; ldk = DM; soff = 1024; doff = WS_WKR; }
            else if ((r -= I_IN) < I_IN8) { idx = I_WIN; N = 6208; nbn = 160; ldk = DM; doff = WS_WIN; f8 = true; }
            else if ((r -= I_IN8) < I_UQ) { idx = I_WUQ; N = 3072; nbn = 96; ldk = 512; doff = WS_WUQ; f8 = true; }
            else if ((r -= I_UQ) < I_UKV) { idx = I_WUKV; N = 4096; nbn = 128; ldk = 512; doff = WS_WUKV; f8 = true; }
            else if ((r -= I_UKV) < I_PL) { const int g = r / 64; r -= g * 64; idx = I_WPOOL; N = 512; nbn = 16; ldk = 256; soff = (size_t)g * 256 * 512; doff = WS_WPOOL + (size_t)g * 512 * 256 * 2; }
            else { r -= I_PL; idx = I_WOUT; N = DM; nbn = 64; ldk = DM; doff = WS_WOUT; }
            const int kb = r / nbn, nb = r - kb * nbn, n0 = nb * 32;
            int dst = n0;
            if (idx == I_WIN && f8 && n0 >= 1024) soff = 1088;
            if (idx == I_WIN && !f8 && n0 >= 64) { dst = n0 - 64; doff = WS_WIN + 16 * MiB; }
            const float* src = p.in[idx] + soff;
            if (f8) transpose_item_fp8(src, N, kb * 128, n0, ws + doff, ldk, dst, scr, lane, idx == I_WUQ ? p.in[I_GQL] : (idx == I_WUKV ? p.in[I_GKVL] : nullptr));
            else transpose_item(src, N, kb * 64, n0, (bf16_t*)(ws + doff), ldk, dst, scr, lane, nullptr);
        }
        for (int i = GT(); i < NE * DM; i += NGT) { const int e = i / DM, k = i % DM; WrT[i] = p.in[I_GFFN][k] * p.in[I_WR][(size_t)k * NE + e]; }
        for (int m = gw; m < T; m += NGW) {
            const f32x4* xr = (const f32x4*)(p.in[I_X] + (size_t)m * DM) + lane; const f32x4* gr = (const f32x4*)p.in[I_GMIX] + lane;
            f32x4 v[8]; float s = 0.f;
#pragma unroll
            for (int j = 0; j < 8; ++j) { v[j] = xr[64 * j]; s += (v[j].x * v[j].x + v[j].y * v[j].y) + (v[j].z * v[j].z + v[j].w * v[j].w); }
            const float rstd = rsqrtf(wave_sum(s) * (1.f / DM) + RMS_EPS);
            u32x2* o8 = (u32x2*)(Hb + (size_t)m * DM) + lane; unsigned* o4 = (unsigned*)(H8 + (size_t)m * DM) + lane;
#pragma unroll
            for (int j = 0; j < 8; ++j) { const f32x4 g = gr[64 * j]; const f32x4 hv = v[j] * rstd * g; u32x2 w; w.x = cvt_pk_bf16(hv.x, hv.y); w.y = cvt_pk_bf16(hv.z, hv.w); o8[64 * j] = w; o4[64 * j] = cvt_pk4_fp8(hv.x, hv.y, hv.z, hv.w); }
        }
        if (BOTH(0)) GRID_BAR();
    }

    if (IN(1)) {
        { pg8::DenseOrder S; S.init((const bf16_t*)H8, DM / 2, (const bf16_t*)Win8, DM / 2, T, 5120, G, bx); pg8::EpiZ E{Zb, ZLD, 1.0f / W8_SCALE, Z8}; pg8::gemm_phase<true>(lds, DM / 2, DM / 2, DM / 2, S, E, wave); }
        { pg8::DenseOrder S; S.init(Hb, DM, WinT, DM, T, 1024, G, bx); pg8::EpiBf16 E{Zb + ZO_POOL, ZLD, 1.0f}; pg8::gemm_phase(lds, DM, DM, DM, S, E, wave); }
        if (BOTH(1)) GRID_BAR();
    }

    if (IN(2)) { LANE_TID();
        bf16_t* WkrT = (bf16_t*)(ws + WS_WKR);
        LAS float* zk = (LAS float*)lds;
        for (int blk = vcu; blk < T / 64; blk += G) {
            {
                const int tt = wave & 1, kq = wave >> 1, j = lane & 31, hh = lane >> 5;
                const bf16_t* hr = Hb + (size_t)(blk * 64 + tt * 32 + j) * DM + kq * 512 + hh * 8;
                const bf16_t* w0 = WkrT + (size_t)j * DM + kq * 512 + hh * 8; const bf16_t* w1 = w0 + (size_t)32 * DM;
                f32x16 a0 = {}, a1 = {};
                bf16x8 hb[32], b0[2][4], b1[2][4];
#pragma unroll
                for (int i = 0; i < 32; ++i) hb[i] = *(const bf16x8*)(hr + i * 16);
#pragma unroll
                for (int i = 0; i < 4; ++i) { b0[0][i] = *(const bf16x8*)(w0 + i * 16); b1[0][i] = *(const bf16x8*)(w1 + i * 16); }
#pragma unroll
                for (int ch = 0; ch < 8; ++ch) {
                    if (ch + 1 < 8) {
#pragma unroll
                        for (int i = 0; i < 4; ++i) { b0[(ch + 1) & 1][i] = *(const bf16x8*)(w0 + (ch + 1) * 64 + i * 16); b1[(ch + 1) & 1][i] = *(const bf16x8*)(w1 + (ch + 1) * 64 + i * 16); } }
#pragma unroll
                    for (int i = 0; i < 4; ++i) { a0 = __builtin_amdgcn_mfma_f32_32x32x16_bf16(b0[ch & 1][i], hb[ch * 4 + i], a0, 0, 0, 0); a1 = __builtin_amdgcn_mfma_f32_32x32x16_bf16(b1[ch & 1][i], hb[ch * 4 + i], a1, 0, 0, 0); }
                }
                LAS float* pp = zk + (kq * 64 + tt * 32 + j) * 65;
#pragma unroll
                for (int r = 0; r < 16; ++r) { const int c = (r & 3) + 8 * (r >> 2) + 4 * hh; pp[c] = a0[r]; pp[32 + c] = a1[r]; }
            }
            __syncthreads();
            const float inv_freq = powf(10000.0f, -(float)(2 * (lane & 31)) / 64.0f);
#pragma unroll 1
            for (int tl = wave * 8; tl < wave * 8 + 8; ++tl) {
                const int m = blk * 64 + tl;
                const bf16_t* zr = Zb + (size_t)m * ZLD;
                {
                    const u32x4 zq = *(const u32x4*)(zr + lane * 8), zkv = *(const u32x4*)(zr + 512 + lane * 8);
                    const float vq[8] = {bf_lo(zq.x), bf_hi(zq.x), bf_lo(zq.y), bf_hi(zq.y), bf_lo(zq.z), bf_hi(zq.z), bf_lo(zq.w), bf_hi(zq.w)};
                    const float vk[8] = {bf_lo(zkv.x), bf_hi(zkv.x), bf_lo(zkv.y), bf_hi(zkv.y), bf_lo(zkv.z), bf_hi(zkv.z), bf_lo(zkv.w), bf_hi(zkv.w)};
                    float sq = 0.f, sk = 0.f;
#pragma unroll
                    for (int q = 0; q < 8; ++q) { sq += vq[q] * vq[q]; sk += vk[q] * vk[q]; }
                    sq = wave_sum(sq); sk = wave_sum(sk);
                    if (lane == 0) { RSQ[m] = rsqrtf(sq * (1.f / 512.f) + RMS_EPS); RSKV[m] = rsqrtf(sk * (1.f / 512.f) + RMS_EPS); }
                }
                {
                    const float pos = (float)((const int*)p.in[I_POS])[m];
                    const int i = lane & 31;
                    const float ang = pos * inv_freq; float sn, cs; sincosf(ang, &sn, &cs);
                    if (lane < 32) { CS[(size_t)m * 64 + i] = cs; CS[(size_t)m * 64 + 32 + i] = sn; }
                    float z1 = 0.f, z2 = 0.f;
#pragma unroll
                    for (int q = 0; q < 4; ++q) { z1 += zk[(q * 64 + tl) * 65 + i]; z2 += zk[(q * 64 + tl) * 65 + 32 + i]; }
                    float sm = (lane < 32) ? (z1 * z1 + z2 * z2) : 0.f;
                    const float rstd = rsqrtf(wave_sum(sm) * (1.f / 64.f) + RMS_EPS);
                    const float t1 = z1 * (rstd * att::KSC) * p.in[I_GKR][i], t2 = z2 * (rstd * att::KSC) * p.in[I_GKR][32 + i];
                    const float o1 = t1 * cs - t2 * sn, o2 = t2 * cs + t1 * sn;
                    const unsigned pk = cvt_pk4_fp8(o1, o2, 0.f, 0.f);
                    const int pp1 = 32 * ((i >> 3) & 1) + 8 * (i >> 4) + (i & 7);
                    if (lane < 32) { KPE8[(size_t)m * 64 + pp1] = (unsigned char)(pk & 0xffu); KPE8[(size_t)m * 64 + pp1 + 16] = (unsigned char)((pk >> 8) & 0xffu); }
                }
            }
            __syncthreads();
        }
#define POOL_BODY(W) do { u32x4 z[15 + W];                                                                                   \
            _Pragma("unroll") for (int t = 0; t < 16; ++t) z[W - 1 + t] = *(const u32x4*)(zp + (size_t)t * ZLD);              \
            _Pragma("unroll") for (int j = 1; j < W; ++j) z[W - 1 - j] = (sp0 - j >= 0) ? *(const u32x4*)(zp - (size_t)j * ZLD) : (u32x4){0u, 0u, 0u, 0u};   \
            float a[8] = {0.f, 0.f, 0.f, 0.f, 0.f, 0.f, 0.f, 0.f};                                                           \
            _Pragma("unroll") for (int j = 1; j < W; ++j) { const u32x4 h = z[W - 1 - j]; a[0] += bf_lo(h.x); a[1] += bf_hi(h.x); a[2] += bf_lo(h.y); a[3] += bf_hi(h.y); a[4] += bf_lo(h.z); a[5] += bf_hi(h.z); a[6] += bf_lo(h.w); a[7] += bf_hi(h.w); }   \
            _Pragma("unroll") for (int t = 0; t < 16; ++t) { const u32x4 c = z[W - 1 + t];                                    \
                const float u0[8] = {bf_lo(c.x), bf_hi(c.x), bf_lo(c.y), bf_hi(c.y), bf_lo(c.z), bf_hi(c.z), bf_lo(c.w), bf_hi(c.w)};                             \
                _Pragma("unroll") for (int q = 0; q < 8; ++q) a[q] += u0[q];                                                  \
                const int cnt = (sp0 + t + 1) < W ? (sp0 + t + 1) : W; const float inv = 1.0f / (float)cnt;                   \
                u32x4 o; o.x = cvt_pk_bf16(a[0] * inv - u0[0], a[1] * inv - u0[1]); o.y = cvt_pk_bf16(a[2] * inv - u0[2], a[3] * inv - u0[3]);                     \
                o.z = cvt_pk_bf16(a[4] * inv - u0[4], a[5] * inv - u0[5]); o.w = cvt_pk_bf16(a[6] * inv - u0[6], a[7] * inv - u0[7]);                             \
                *(u32x4*)(op + (size_t)t * 1024) = o;                                                                         \
                const u32x4 l = z[t];                                       \
                a[0] -= bf_lo(l.x); a[1] -= bf_hi(l.x); a[2] -= bf_lo(l.y); a[3] -= bf_hi(l.y); a[4] -= bf_lo(l.z); a[5] -= bf_hi(l.z); a[6] -= bf_lo(l.w); a[7] -= bf_hi(l.w); } } while (0)
        for (int wv = gw; wv < (T / 32) * 4; wv += NGW) {
            const int g = wv & 3, m0 = ((wv >> 2) * 2 + (lane >> 5)) * 16, ch = g * 32 + (lane & 31), sp0 = m0 & (SEQ - 1);
            const bf16_t* zp = Zb + (size_t)m0 * ZLD + ZO_POOL + ch * 8; bf16_t* op = POOLED + (size_t)m0 * 1024 + ch * 8;
            if (g == 0) POOL_BODY(2); else if (g == 1) POOL_BODY(4); else if (g == 2) POOL_BODY(8); else POOL_BODY(16);
        }
#undef POOL_BODY
        if (BOTH(2)) GRID_BAR();
    }

    if (IN(3)) {
        { pg8::DenseOrder S; S.init((const bf16_t*)Z8, 512, WuqT, 256, T, 3072, G, bx); pg8::EpiRowScale E{Qb, 3072, RSQ}; pg8::gemm_phase<true>(lds, 256, 512, 256, S, E, wave); }
        { pg8::DenseOrder S; S.init((const bf16_t*)(Z8 + 512), 512, WukvT, 256, T, 4096, G, bx); pg8::EpiKV E{K8b, V8T, RSKV, p.in[I_GKN], p.in[I_GQN], (LAS float*)(lds + 131072)}; pg8::gemm_phase<true>(lds, 256, 512, 256, S, E, wave); }
        if (BOTH(3)) GRID_BAR();
    }


    if (IN(5)) {
        const att::QNorm QN{CS, p.in[I_GQN], p.in[I_GQR]};
        const int grp = (bx >> 3) % 5;
#define CONV_SLOT(g) do { if (grp == (g)) { const int lane = lane_id(); convert_expert_weights(p.in[I_WGU], p.in[I_WD], WguT, WdT, (LAS float*)(lds + wave * 16896), gw, NGW, lane); } __syncthreads(); } while (0)
        CONV_SLOT(0);
        att::attn_phase<0>((char*)lds_raw, Qb, V8T, K8b, KPE8, YA, 2 * G, bx, wave, QN);
        CONV_SLOT(1);
        att::attn_phase<1>((char*)lds_raw, Qb, V8T, K8b, KPE8, YA, 2 * G, bx, wave, QN);
        CONV_SLOT(2);
        att::attn_phase<0>((char*)lds_raw, Qb, V8T, K8b, KPE8, YA, 2 * G, bx + G, wave, QN);
        CONV_SLOT(3);
        att::attn_phase<1>((char*)lds_raw, Qb, V8T, K8b, KPE8, YA, 2 * G, bx + G, wave, QN);
        CONV_SLOT(4);
#undef CONV_SLOT
        if (BOTH(5)) GRID_BAR();
    }

    if (IN(6)) {
        { pg8::PoolOrder S; S.init(POOLED, 1024, WpoolT, 256, T, 2048, G, bx); pg8::EpiPool E{MERGED, Zb, YA, p.in[I_SPOOL]}; pg8::gemm_phase(lds, 256, 1024, 256, S, E, wave); }
        if (BOTH(6)) GRID_BAR();
    }

    if (IN(7)) {
        pg8::DenseOrder S; S.init(MERGED, DM, WoutT, DM, T, DM, G, bx);
        pg8::EpiOut E{p.in[I_X], X1, H2, p.in[I_GFFN]};
        pg8::gemm_phase(lds, DM, DM, DM, S, E, wave);
        if (BOTH(7)) GRID_BAR();
    }

    if (IN(8)) { LANE_TID();
        LAS float* part = (LAS float*)lds;
        LAS float* ssq = (LAS float*)(lds + 36864);
        LAS int* lrk = (LAS int*)(lds + 40960);
        LAS int* hist = (LAS int*)(lds + 53760);
        LAS int* base = (LAS int*)(lds + 54016);
        unsigned* cnt = ctl + CW_CNT;
        for (int blk = vcu; blk < T / 64; blk += G) {
            const int tt = wave & 1, kq = wave >> 1, j = lane & 31, hh = lane >> 5;
            if (tid < 32) hist[tid] = 0;
            {
                const bf16_t* xr = X1 + (size_t)(blk * 64 + tt * 32 + j) * DM + kq * 512 + hh * 4;
                const float* wr_ = WrT + (size_t)j * DM + kq * 512 + hh * 4;
                f32x16 acc = {}; float ss = 0.f;
                u32x2 xb[2][8]; f32x4 wb[2][8];
#pragma unroll
                for (int i = 0; i < 8; ++i) { xb[0][i] = *(const u32x2*)(xr + i * 8); wb[0][i] = *(const f32x4*)(wr_ + i * 8); }
#pragma unroll
                for (int ch = 0; ch < 8; ++ch) {
                    if (ch + 1 < 8) {
#pragma unroll
                        for (int i = 0; i < 8; ++i) { xb[(ch + 1) & 1][i] = *(const u32x2*)(xr + (ch + 1) * 64 + i * 8); wb[(ch + 1) & 1][i] = *(const f32x4*)(wr_ + (ch + 1) * 64 + i * 8); } }
#pragma unroll
                    for (int i = 0; i < 8; ++i) { const u32x2 xp = xb[ch & 1][i]; const f32x4 xv = {bf_lo(xp.x), bf_hi(xp.x), bf_lo(xp.y), bf_hi(xp.y)}, wv = wb[ch & 1][i];
                        acc = __builtin_amdgcn_mfma_f32_32x32x2f32(wv.x, xv.x, acc, 0, 0, 0); acc = __builtin_amdgcn_mfma_f32_32x32x2f32(wv.y, xv.y, acc, 0, 0, 0);
                        acc = __builtin_amdgcn_mfma_f32_32x32x2f32(wv.z, xv.z, acc, 0, 0, 0); acc = __builtin_amdgcn_mfma_f32_32x32x2f32(wv.w, xv.w, acc, 0, 0, 0);
                        ss += (xv.x * xv.x + xv.y * xv.y) + (xv.z * xv.z + xv.w * xv.w); }
                }
                LAS float* pp = part + ((kq * 2 + tt) * 32 + j) * 33;
#pragma unroll
                for (int r = 0; r < 16; ++r) pp[(r & 3) + 8 * (r >> 2) + 4 * hh] = acc[r];
                ssq[((kq * 2 + tt) * 32 + j) * 2 + hh] = ss;
            }
            __syncthreads();
            int te[4];
            if (tid < 64) {
                const int t2 = tid >> 5, jj = tid & 31, tok = blk * 64 + tid;
                float s = 0.f;
#pragma unroll
                for (int q = 0; q < 4; ++q) s += ssq[((q * 2 + t2) * 32 + jj) * 2] + ssq[((q * 2 + t2) * 32 + jj) * 2 + 1];
                const float rstd = rsqrtf(s * (1.f / DM) + RMS_EPS);
                RS2[tok] = rstd;
                float lgv[NE];
#pragma unroll
                for (int e = 0; e < NE; ++e) { float v = 0.f;
#pragma unroll
                    for (int q = 0; q < 4; ++q) v += part[((q * 2 + t2) * 32 + jj) * 33 + e];
                    lgv[e] = v * rstd + p.in[I_BR][e]; }
                unsigned mask = 0u; float tv[4];
#pragma unroll
                for (int k = 0; k < 4; ++k) { float best = -__builtin_inff(); int be = 0;
#pragma unroll
                    for (int e = 0; e < NE; ++e) { const bool take = !((mask >> e) & 1u) && lgv[e] > best; best = take ? lgv[e] : best; be = take ? e : be; }
                    mask |= 1u << be; tv[k] = best; te[k] = be; }
                float ex[4], sum = 0.f;
#pragma unroll
                for (int k = 0; k < 4; ++k) { ex[k] = __expf(tv[k] - tv[0]); sum += ex[k]; }
                const float inv = 1.0f / sum;
#pragma unroll
                for (int k = 0; k < 4; ++k) { lrk[tid * 4 + k] = atomicAdd((int*)&hist[te[k]], 1); tok_e[tok * 4 + k] = te[k]; tok_w[tok * 4 + k] = ex[k] * inv; }
            }
            __syncthreads();
            if (tid < 32) base[tid] = (int)__hip_atomic_fetch_add(cnt + tid, (unsigned)hist[tid], RLX_AGENT);
            __syncthreads();
            if (tid < 64) { const int tok = blk * 64 + tid; const float rsv = RS2[tok];
#pragma unroll
                for (int k = 0; k < 4; ++k) { const int rk = base[te[k]] + lrk[tid * 4 + k]; tok_rank[tok * 4 + k] = rk; lrk[tid * 4 + k] = te[k] * XCAP + rk;
                    row_w[(size_t)te[k] * XCAP + rk] = tok_w[tok * 4 + k]; row_rs[(size_t)te[k] * XCAP + rk] = rsv; } }
            __syncthreads();
            for (int q0 = wave; q0 < 256; q0 += 64) {
                u32x4 ra[8], rb[8]; int srow[8];
#pragma unroll
                for (int u = 0; u < 8; ++u) { const int q = q0 + 8 * u; srow[u] = lrk[q]; const u32x4* src = (const u32x4*)(H2 + (size_t)(blk * 64 + (q >> 2)) * DM) + lane; ra[u] = src[0]; rb[u] = src[64]; }
#pragma unroll
                for (int u = 0; u < 8; ++u) { u32x4* dst = (u32x4*)(XS + (size_t)srow[u] * DM) + lane; dst[0] = ra[u]; dst[64] = rb[u]; } }
            __syncthreads();
        }
        if (BOTH(8)) GRID_BAR();
    }

    LAS int* ts = (LAS int*)(lds + MISC_OFF + 256);

    if (IN(10)) { LANE_TID();
        moe_tables(ctl + CW_CNT, ts, tid);
        pg8::MoeOrder S; S.init(XS, 1, WguT, (size_t)4096 * DM, DM, ts, 16, G, bx);
        pg8::EpiSwiglu E{ACT, p.in[I_BGU], row_rs};
        pg8::gemm_phase<true>(lds, DM / 2, DM / 2, DM / 2, S, E, wave);
        if (BOTH(10)) GRID_BAR();
    }

    if (IN(11)) { LANE_TID();
        moe_tables(ctl + CW_CNT, ts, tid);
        pg8::MoeOrder S; S.init(ACT, 0, WdT, (size_t)DM * DFF, DFF, ts, 8, G, bx);
        pg8::EpiDown E{Yb, p.in[I_BD], row_w};
        pg8::gemm_phase<true>(lds, DFF / 2, DFF / 2, DFF / 2, S, E, wave);
        if (BOTH(11)) GRID_BAR();
    }

    if (IN(12)) { LANE_TID();
        moe_tables(ctl + CW_CNT, ts, tid);
        constexpr int NI = T * (DM / 16), UN = 4;
        for (int it0 = GT(); it0 < NI; it0 += UN * NGT) {
            int mm[UN], cc[UN], ee[UN][4], rk[UN][4]; u32x4 xa[UN], xb[UN], y[UN][4];
#pragma unroll
            for (int u = 0; u < UN; ++u) { const int it = it0 + u * NGT < NI ? it0 + u * NGT : it0; mm[u] = it >> 7; cc[u] = (it & 127) * 16;
                const i32x4 e4 = *(const i32x4*)(tok_e + mm[u] * 4), r4 = *(const i32x4*)(tok_rank + mm[u] * 4);
#pragma unroll
                for (int k = 0; k < 4; ++k) { ee[u][k] = e4[k]; rk[u][k] = r4[k]; }
                const bf16_t* xp = X1 + (size_t)mm[u] * DM + cc[u]; xa[u] = *(const u32x4*)xp; xb[u] = *(const u32x4*)(xp + 8); }
#pragma unroll
            for (int u = 0; u < UN; ++u)
#pragma unroll
                for (int k = 0; k < 4; ++k) { const int pos = ts[ee[u][k]] * 256 + rk[u][k]; y[u][k] = *(const u32x4*)(Yb + (size_t)pos * DM + cc[u]); }
#pragma unroll
            for (int u = 0; u < UN; ++u) {
                f32x4 a[4];
                a[0] = (f32x4){bf_lo(xa[u].x), bf_hi(xa[u].x), bf_lo(xa[u].y), bf_hi(xa[u].y)}; a[1] = (f32x4){bf_lo(xa[u].z), bf_hi(xa[u].z), bf_lo(xa[u].w), bf_hi(xa[u].w)};
                a[2] = (f32x4){bf_lo(xb[u].x), bf_hi(xb[u].x), bf_lo(xb[u].y), bf_hi(xb[u].y)}; a[3] = (f32x4){bf_lo(xb[u].z), bf_hi(xb[u].z), bf_lo(xb[u].w), bf_hi(xb[u].w)};
#pragma unroll
                for (int k = 0; k < 4; ++k)
#pragma unroll
                    for (int q = 0; q < 4; ++q) { const f32x2 lo = __builtin_amdgcn_cvt_pk_f32_fp8((int)y[u][k][q], false), hi = __builtin_amdgcn_cvt_pk_f32_fp8((int)y[u][k][q], true);
                        a[q].x += lo.x * (1.0f / Y8_SCALE); a[q].y += lo.y * (1.0f / Y8_SCALE); a[q].z += hi.x * (1.0f / Y8_SCALE); a[q].w += hi.y * (1.0f / Y8_SCALE); }
                if (it0 + u * NGT < NI) { float* op = p.out + (size_t)mm[u] * DM + cc[u];
#pragma unroll
                    for (int q = 0; q < 4; ++q) *(f32x4*)(op + 4 * q) = a[q]; }
            }
        }
    }
#undef IN
#undef BOTH
#undef GRID_BAR
}

#ifndef PROBE_AV
#define PROBE_AV -1
#endif
#if PROBE_AV >= 0
__global__ void __launch_bounds__(512, 2) probe_attn_kernel(Params p) {
    extern __shared__ __attribute__((aligned(16))) unsigned char lds_raw[];
    const int wave = __builtin_amdgcn_readfirstlane((int)threadIdx.x >> 6);
    const int G = gridDim.x, bx = blockIdx.x;
    unsigned char* ws = p.ws;
    const att::QNorm QN{(float*)(ws + WS_CS), p.in[I_GQN], p.in[I_GQR]};
    const bf16_t* Qb = (const bf16_t*)(ws + WS_Q); bf16_t* YA = (bf16_t*)(ws + WS_YA);
    att::attn_phase<0, PROBE_AV>((char*)lds_raw, Qb, ws + WS_KV, ws + WS_NQ, ws + WS_KPE, YA, 2 * G, bx, wave, QN);
    att::attn_phase<1, PROBE_AV>((char*)lds_raw, Qb, ws + WS_KV, ws + WS_NQ, ws + WS_KPE, YA, 2 * G, bx, wave, QN);
    att::attn_phase<0, PROBE_AV>((char*)lds_raw, Qb, ws + WS_KV, ws + WS_NQ, ws + WS_KPE, YA, 2 * G, bx + G, wave, QN);
    att::attn_phase<1, PROBE_AV>((char*)lds_raw, Qb, ws + WS_KV, ws + WS_NQ, ws + WS_KPE, YA, 2 * G, bx + G, wave, QN);
}
#endif

extern "C" void kernel_launch(void* const* d_in, const int* in_sizes, int n_in, void* d_out, int out_size, void* d_ws, size_t ws_size, hipStream_t stream) {
    static int grid = 0;
    if (grid == 0) {
        if (n_in != 22 || out_size != T * DM || ws_size < WS_END) { fprintf(stderr, "kernel_launch: unexpected shapes (n_in %d, out %d, ws %zu)\n", n_in, out_size, ws_size); grid = -1; return; }
        int dev = 0, cus = 0, per_cu = 0;
        if (hipGetDevice(&dev) != hipSuccess || hipDeviceGetAttribute(&cus, hipDeviceAttributeMultiprocessorCount, dev) != hipSuccess) { grid = -1; return; }
        if (hipFuncSetAttribute((const void*)fwd_kernel, hipFuncAttributeMaxDynamicSharedMemorySize, LDS_BYTES) != hipSuccess) { fprintf(stderr, "kernel_launch: hipFuncSetAttribute failed\n"); grid = -1; return; }
        if (hipOccupancyMaxActiveBlocksPerMultiprocessor(&per_cu, (const void*)fwd_kernel, 512, LDS_BYTES) != hipSuccess || per_cu < 1) fprintf(stderr, "kernel_launch: occupancy query reports %d\n", per_cu);
        (void)hipGetLastError();
        grid = cus;
    }
    if (grid < 0) return;
    (void)hipMemsetAsync((char*)d_ws + WS_CTL, 0, CTL_ZERO_BYTES, stream);
    Params p{};
    for (int i = 0; i < 22; ++i) p.in[i] = (const float*)d_in[i];
    p.out = (float*)d_out; p.ws = (unsigned char*)d_ws;
    for (int li = 0; li < N_LAUNCHES; ++li) {
        if (N_LAUNCHES == 1) { p.ph_lo = 0; p.ph_hi = NPH; } else { p.ph_lo = li; p.ph_hi = li + 1; }
        hipLaunchKernelGGL(fwd_kernel, dim3(grid), dim3(512), LDS_BYTES, stream, p);
    }
#if PROBE_AV >= 0
    (void)hipFuncSetAttribute((const void*)probe_attn_kernel, hipFuncAttributeMaxDynamicSharedMemorySize, LDS_BYTES);
    hipLaunchKernelGGL(probe_attn_kernel, dim3(grid), dim3(512), LDS_BYTES, stream, p);
#endif
    if (PROBE_PHASE >= 0) { p.ph_lo = PROBE_PHASE; p.ph_hi = PROBE_PHASE + 1; hipLaunchKernelGGL(fwd_kernel, dim3(grid), dim3(512), LDS_BYTES, stream, p); }
}
```

```cpp
#include <hip/hip_runtime.h>
#include <cstdio>
#include <cstdint>

#ifndef MK_N_LAUNCHES
#define MK_N_LAUNCHES 1
#endif
#ifndef PROBE_PHASE
#define PROBE_PHASE -1
#endif

#define GAS __attribute__((address_space(1)))
#define LAS __attribute__((address_space(3)))
typedef unsigned short bf16_t;
typedef short bf16x8 __attribute__((ext_vector_type(8)));
typedef short s16x4 __attribute__((ext_vector_type(4)));
typedef float f32x2 __attribute__((ext_vector_type(2)));
typedef float f32x4 __attribute__((ext_vector_type(4)));
typedef float f32x16 __attribute__((ext_vector_type(16)));
typedef unsigned u32x2 __attribute__((ext_vector_type(2)));
typedef unsigned u32x4 __attribute__((ext_vector_type(4)));
typedef int i32x4 __attribute__((ext_vector_type(4)));
typedef int i32x8 __attribute__((ext_vector_type(8)));

constexpr int T = 16384, SEQ = 8192, DM = 2048, NH = 16;
constexpr int ZW = 6144;
constexpr int ZO_Q = 0, ZO_KV = 512, ZO_GA = 1024, ZO_GP = 3072, ZO_POOL = 5120;
constexpr int ZLD = 6272;
constexpr int NE = 32, TOPK = 4, DFF = 2048;
constexpr int XCAP = 16384;
constexpr int MT_MAX = 288, MP_MAX = MT_MAX * 256;
constexpr float RMS_EPS = 1e-6f;
constexpr float W8_SCALE = 64.0f, ACT8_SCALE = 4.0f, Y8_SCALE = 16.0f;
constexpr int NPH = 13;
constexpr int N_LAUNCHES = MK_N_LAUNCHES;

constexpr size_t MiB = 1u << 20;
constexpr size_t WS_CTL = 0, CTL_ZERO_BYTES = 1 * MiB;
constexpr size_t WS_WIN = 2 * MiB, WS_WUQ = 28 * MiB, WS_WUKV = 32 * MiB, WS_WPOOL = 36 * MiB, WS_WOUT = 38 * MiB, WS_WRT = 46 * MiB;
constexpr size_t WS_WKR = 47 * MiB;
constexpr size_t WS_ROUTE = 48 * MiB;
constexpr size_t WS_CS = 50 * MiB;
constexpr size_t WS_KPE = 54 * MiB, WS_NQ = 56 * MiB, WS_NKV = 72 * MiB, WS_POOLED = 88 * MiB, WS_H = 120 * MiB, WS_YP = 184 * MiB, WS_YA = 248 * MiB;
constexpr size_t WS_MERGED = 312 * MiB, WS_H2 = 376 * MiB, WS_Q = 440 * MiB, WS_KV = 536 * MiB, WS_Z = 664 * MiB, WS_WGU = 864 * MiB, WS_WD = 1376 * MiB;
constexpr size_t WS_XS = 1632 * MiB, WS_ACT = 1920 * MiB, WS_Y = 2208 * MiB, WS_X1 = 2496 * MiB;
constexpr size_t WS_H8 = 2624 * MiB, WS_WIN8 = 2656 * MiB, WS_ROWT = 2664 * MiB, WS_XSP = 2672 * MiB, WS_END = 3696 * MiB;
constexpr int CW_TMO = 0, CW_CODE = 1, CW_BAR = 4096, CW_CNT = 8192;

constexpr int RING_BYTES = 151552;
constexpr int MISC_OFF = RING_BYTES;
constexpr int LDS_BYTES = 155648;

#define RLX_AGENT __ATOMIC_RELAXED, __HIP_MEMORY_SCOPE_AGENT
#define LDS_WAIT() asm volatile("s_waitcnt lgkmcnt(0)" ::: "memory")
#define VM_WAIT() asm volatile("s_waitcnt vmcnt(0)" ::: "memory")

__device__ __forceinline__ unsigned cvt_pk_bf16(float lo, float hi) { unsigned r; asm volatile("v_cvt_pk_bf16_f32 %0, %1, %2" : "=v"(r) : "v"(lo), "v"(hi)); return r; }
__device__ __forceinline__ unsigned cvt_pk4_fp8(float a, float b, float c, float d) { int w; asm("" : "=v"(w));     w = __builtin_amdgcn_cvt_pk_fp8_f32(a, b, w, false); w = __builtin_amdgcn_cvt_pk_fp8_f32(c, d, w, true); return (unsigned)w; }
__device__ __forceinline__ float bf_lo(unsigned w) { return __uint_as_float(w << 16); }
__device__ __forceinline__ float bf_hi(unsigned w) { return __uint_as_float(w & 0xffff0000u); }
__device__ __forceinline__ float sigmoidf_(float x) { return __builtin_amdgcn_rcpf(1.0f + __builtin_amdgcn_exp2f(-1.4426950408889634f * x)); }
__device__ __forceinline__ int lane_id() { int l; asm volatile("v_mbcnt_lo_u32_b32 %0, -1, 0\n\tv_mbcnt_hi_u32_b32 %0, -1, %0" : "=v"(l)); return l; }
__device__ __forceinline__ float wave_sum(float v) {
#pragma unroll
    for (int o = 1; o < 64; o <<= 1) v += __shfl_xor(v, o);
    return v;
}

#define XB_TMO      128
#define XB_XCNT(j)  (256  + 64 * (j))
#define XB_XSUB(j)  (1280 + 64 * (j))
#define XB_XGEN(j)  (2304 + 64 * (j))
#define XB_TOP      3328
#define XB_TOPGEN   3392
#define XCD_BAR_WORDS 3456
#define XB_SPIN_CAP (1u << 22)
__device__ __forceinline__ unsigned xb_ld(unsigned* p)              { return __hip_atomic_load(p, __ATOMIC_RELAXED, __HIP_MEMORY_SCOPE_AGENT); }
__device__ __forceinline__ unsigned xb_add(unsigned* p, unsigned v) { return __hip_atomic_fetch_add(p, v, __ATOMIC_RELAXED, __HIP_MEMORY_SCOPE_AGENT); }
__device__ __forceinline__ unsigned xb_xcc_id() { return (unsigned)__builtin_amdgcn_s_getreg((3 << 11) | 20) & 0xFu; }
#define XB_SPIN(cond, bar) do { unsigned _sp = 0; while (cond) { __builtin_amdgcn_s_sleep(1); \
    if ((++_sp & 255u) == 0u) { if (xb_ld(&(bar)[XB_TMO])) break; if (_sp > XB_SPIN_CAP) { atomicAdd(&(bar)[XB_TMO], 1u); break; } } } } while (0)
struct XcdBarrier { unsigned* bar; unsigned x; volatile LAS unsigned* st; };
__device__ __forceinline__ XcdBarrier xcd_barrier_post(unsigned* bar, volatile LAS unsigned* st, bool leader) {
    XcdBarrier b; b.bar = bar; b.x = xb_xcc_id(); b.st = st;
    if (leader) (void)xb_add(&bar[XB_XCNT(b.x)], 1u);
    return b;
}
__device__ __forceinline__ void xcd_barrier_complete(unsigned* bar, unsigned x, unsigned& nloc, unsigned& nx) {
    const unsigned G = gridDim.x * gridDim.y * gridDim.z;
    unsigned sum, cnt, mine, sp = 0u;
    for (;;) {
        sum = 0u; cnt = 0u; mine = 0u;
#pragma unroll
        for (unsigned j = 0; j < 16; ++j) { const unsigned c = xb_ld(&bar[XB_XCNT(j)]); sum += c; cnt += (c > 0u) ? 1u : 0u; mine = (j == x) ? c : mine; }
        if (sum == G) break;
        __builtin_amdgcn_s_sleep(1);
        if ((++sp & 255u) == 0u) { if (xb_ld(&bar[XB_TMO])) break; if (sp > XB_SPIN_CAP) { atomicAdd(&bar[XB_TMO], 1u); break; } }
    }
    nloc = mine > 0u ? mine : 1u; nx = cnt > 0u ? cnt : 1u;
}
__device__ __forceinline__ void xcd_barrier(const XcdBarrier& b, bool leader) {
    asm volatile("s_waitcnt vmcnt(0)" ::: "memory");
    __syncthreads();
    if (leader) {
        unsigned* bar = b.bar;
        __builtin_amdgcn_s_waitcnt(0);
        unsigned nloc = b.st[0], nx = b.st[1];
        if (nloc == 0u) { xcd_barrier_complete(bar, b.x, nloc, nx); b.st[0] = nloc; b.st[1] = nx; }
        const unsigned old = xb_add(&bar[XB_XSUB(b.x)], 1u);
        const unsigned gen = old / nloc;
        if (old + 1u == (gen + 1u) * nloc) {
            __builtin_amdgcn_fence(__ATOMIC_RELEASE, "agent");
            asm volatile("s_waitcnt vmcnt(0)" ::: "memory");
            const unsigned og = xb_add(&bar[XB_TOP], 1u);
            const unsigned tg = og / nx;
            if (og + 1u == (tg + 1u) * nx) xb_add(&bar[XB_TOPGEN], 1u);
            else XB_SPIN(xb_ld(&bar[XB_TOPGEN]) == tg, bar);
            __builtin_amdgcn_fence(__ATOMIC_ACQUIRE, "agent");
            xb_add(&bar[XB_XGEN(b.x)], 1u);
            asm volatile("s_waitcnt vmcnt(0)" ::: "memory");
        } else {
            XB_SPIN(xb_ld(&bar[XB_XGEN(b.x)]) == gen, bar);
            __builtin_amdgcn_fence(__ATOMIC_ACQUIRE, "agent");
            asm volatile("s_waitcnt vmcnt(0)" ::: "memory");
        }
    }
    __syncthreads();
}

namespace pg8 {
constexpr int BM = 256, BK = 64, HALF = 128, HTB = HALF * BK * 2, STAGE_BYTES = 8 * HTB, NXCD = 8, WGM = 8;
__host__ __device__ __forceinline__ int lds_byte(int r, int c) { const int st = (r >> 4) * 2 + (c >> 5), rr = r & 15, cc = c & 31, ob = rr * 64 + cc * 2; return st * 1024 + (ob ^ (((ob >> 9) & 1) << 5)); }
__host__ __device__ __forceinline__ void stage_rc(int b, int& R, int& C) { const int st = b / 1024, sb = b % 1024, swz = sb ^ (((sb >> 9) & 1) << 5); R = (st >> 1) * 16 + swz / 64; C = (st & 1) * 32 + (swz % 64) / 2; }
__host__ __device__ __forceinline__ int perm32(int rho) { const int n = rho >> 4, i = rho & 15; return 8 * (i >> 2) + 4 * n + (i & 3); }

struct Unit { int pm, pn, e, lr0; const char* A; const char* B; };
__device__ __forceinline__ int xcd_chunk(int L, int nwg) { const int q = nwg / NXCD, r = nwg % NXCD, xcd = L % NXCD, off = L / NXCD; return (xcd < r ? xcd * (q + 1) : r * (q + 1) + (xcd - r) * q) + off; }

struct DenseOrder {
    const char* A; const char* Bt; int lda, ldb; int nM, nN, nwg, G, c;
    __device__ __forceinline__ void init(const bf16_t* A_, int lda_, const bf16_t* Bt_, int ldb_, int M, int N, int G_, int c_) { A = (const char*)A_; Bt = (const char*)Bt_; lda = lda_; ldb = ldb_; nM = M / BM; nN = N / BM; nwg = nM * nN; G = G_; c = c_; }
    __device__ __forceinline__ bool next(int i, Unit& u) const {
        const int L = i * G + c; if (L >= nwg) return false;
        const int wgid = xcd_chunk(L, nwg);
        const int nig = WGM * nN, gid = wgid / nig, fm = gid * WGM, gsz = (nM - fm) < WGM ? (nM - fm) : WGM;
        u.pm = fm + ((wgid % nig) % gsz); u.pn = (wgid % nig) / gsz; u.e = 0; u.lr0 = 0;
        u.A = A + (size_t)u.pm * BM * lda * 2; u.B = Bt + (size_t)u.pn * BM * ldb * 2; return true;
    }
};
struct PoolOrder : DenseOrder {
    __device__ __forceinline__ bool next(int i, Unit& u) const {
        if (!DenseOrder::next(i, u)) return false;
        u.A += (size_t)(u.pn >> 1) * 256 * 2; return true;
    }
};
struct MoeOrder {
    const char* A; const char* Bt; size_t estride; const LAS int* ts; int nN, nwg, G, c, rowb, slabA;
    __device__ __forceinline__ void init(const void* A_, int slabA_, const void* Bt_, size_t estride_bytes, int rowbytes, const LAS int* ts_, int nN_, int G_, int c_) { slabA = slabA_; A = (const char*)A_; Bt = (const char*)Bt_; estride = estride_bytes; rowb = rowbytes; ts = ts_; nN = nN_; nwg = __builtin_amdgcn_readfirstlane(ts_[NE]) * nN_; G = G_; c = c_; }
    __device__ __forceinline__ bool next(int i, Unit& u) const {
        const int L = i * G + c; if (L >= nwg) return false;
        const int wgid = xcd_chunk(L, nwg);
        const int lj = lane_id() & 31;
        const unsigned long long bal = __ballot(ts[lj] * nN <= wgid);
        const int e = __builtin_popcount((unsigned)bal) - 1;
        const int t0 = __builtin_amdgcn_readfirstlane(ts[e]), mt = __builtin_amdgcn_readfirstlane(ts[e + 1]) - t0, uu = wgid - t0 * nN;
        const int lt = uu % mt; u.pm = t0 + lt; u.pn = uu / mt; u.e = e; u.lr0 = lt * BM;
        u.A = A + (slabA ? ((size_t)e * XCAP + (size_t)lt * BM) : (size_t)u.pm * BM) * rowb; u.B = Bt + (size_t)e * estride + (size_t)u.pn * BM * rowb; return true;
    }
};

struct EpiBf16 {
    static constexpr bool PERM = true; static constexpr bool PERMA = false;
    bf16_t* O; int ldc; float sc;
    __device__ __forceinline__ void operator()(const f32x4 (&acc)[2][2][4][2], const Unit& u, int wr, int wc, int fr, int fq) const {
        const int row0 = u.pm * BM + wr * 64 + fr, col0 = u.pn * BM + wc * 32 + 8 * fq;
#pragma unroll
        for (int ai = 0; ai < 2; ++ai)
#pragma unroll
            for (int m = 0; m < 4; ++m) { bf16_t* rowp = O + (size_t)(row0 + ai * HALF + m * 16) * ldc + col0;
#pragma unroll
                for (int bj = 0; bj < 2; ++bj) { const f32x4 v0 = acc[ai][bj][m][0] * sc, v1 = acc[ai][bj][m][1] * sc;
                    u32x4 w; w.x = cvt_pk_bf16(v0[0], v0[1]); w.y = cvt_pk_bf16(v0[2], v0[3]); w.z = cvt_pk_bf16(v1[0], v1[1]); w.w = cvt_pk_bf16(v1[2], v1[3]);
                    *(u32x4*)(rowp + bj * HALF) = w; } }
    }
};
struct EpiZ {
    static constexpr bool PERM = true; static constexpr bool PERMA = false;
    bf16_t* O; int ldc; float sc; unsigned char* Z8;
    __device__ __forceinline__ void operator()(const f32x4 (&acc)[2][2][4][2], const Unit& u, int wr, int wc, int fr, int fq) const {
        const int row0 = u.pm * BM + wr * 64 + fr, col0 = u.pn * BM + wc * 32 + 8 * fq;
        const bool lat = u.pn < 4;
#pragma unroll
        for (int ai = 0; ai < 2; ++ai)
#pragma unroll
            for (int m = 0; m < 4; ++m) { const size_t r = (size_t)(row0 + ai * HALF + m * 16); bf16_t* rowp = O + r * ldc + col0;
#pragma unroll
                for (int bj = 0; bj < 2; ++bj) { const f32x4 v0 = acc[ai][bj][m][0] * sc, v1 = acc[ai][bj][m][1] * sc;
                    if (lat) { u32x2 z; z.x = cvt_pk4_fp8(v0[0], v0[1], v0[2], v0[3]); z.y = cvt_pk4_fp8(v1[0], v1[1], v1[2], v1[3]); *(u32x2*)(Z8 + r * 1024 + col0 + bj * HALF) = z; }
                    else { u32x4 w; w.x = cvt_pk_bf16(v0[0], v0[1]); w.y = cvt_pk_bf16(v0[2], v0[3]); w.z = cvt_pk_bf16(v1[0], v1[1]); w.w = cvt_pk_bf16(v1[2], v1[3]); *(u32x4*)(rowp + bj * HALF) = w; } } }
    }
};
struct EpiRowScale {
    static constexpr bool PERM = true; static constexpr bool PERMA = false;
    bf16_t* O; int ldc; const float* rs;
    __device__ __forceinline__ void operator()(const f32x4 (&acc)[2][2][4][2], const Unit& u, int wr, int wc, int fr, int fq) const {
        const int row0 = u.pm * BM + wr * 64 + fr, col0 = u.pn * BM + wc * 32 + 8 * fq;
#pragma unroll
        for (int ai = 0; ai < 2; ++ai)
#pragma unroll
            for (int m = 0; m < 4; ++m) { const int r = row0 + ai * HALF + m * 16; const float c = rs[r] * (1.0f / W8_SCALE);     bf16_t* rowp = O + (size_t)r * ldc + col0;
#pragma unroll
                for (int bj = 0; bj < 2; ++bj) { const f32x4 v0 = acc[ai][bj][m][0] * c, v1 = acc[ai][bj][m][1] * c;
                    u32x4 w; w.x = cvt_pk_bf16(v0[0], v0[1]); w.y = cvt_pk_bf16(v0[2], v0[3]); w.z = cvt_pk_bf16(v1[0], v1[1]); w.w = cvt_pk_bf16(v1[2], v1[3]);
                    *(u32x4*)(rowp + bj * HALF) = w; } }
    }
};
constexpr float KSC_ = 1.4426950408889634f * 0.07216878364870322f / 0.25f;
struct EpiKV {
    static constexpr bool PERM = true; static constexpr bool PERMA = true;
    unsigned char* K8; unsigned char* V8T; const float* rs; const float* gk; const float* gq; LAS float* xch;
    __device__ __forceinline__ void operator()(const f32x4 (&acc)[2][2][4][2], const Unit& u, int wr, int wc, int fr, int fq) const {
        const int rl0 = wr * 64 + 4 * fr, dl0 = wc * 32 + 8 * fq;
#pragma unroll
        for (int ai = 0; ai < 2; ++ai)
#pragma unroll
            for (int m = 0; m < 4; ++m) { const int rl = rl0 + ai * HALF + m; const float c = rs[u.pm * BM + rl] * (1.0f / W8_SCALE);
                const f32x4 a = acc[ai][0][m][0] * c, b = acc[ai][0][m][1] * c;
                float q = (a[0] * a[0] + a[1] * a[1]) + (a[2] * a[2] + a[3] * a[3]) + (b[0] * b[0] + b[1] * b[1]) + (b[2] * b[2] + b[3] * b[3]);
                q += __shfl_xor(q, 16); q += __shfl_xor(q, 32);
                if (fq == 0) xch[rl * 4 + wc] = q; }
        asm volatile("s_waitcnt lgkmcnt(0)" ::: "memory"); __builtin_amdgcn_s_barrier(); asm volatile("" ::: "memory");
        const f32x4 g0 = *(const f32x4*)(gk + dl0) * *(const f32x4*)(gq + dl0), g1 = *(const f32x4*)(gk + dl0 + 4) * *(const f32x4*)(gq + dl0 + 4);
        const int kpos = 64 * (wc >> 1) + 32 * (fq & 1) + 8 * ((2 * wc + (fq >> 1)) & 3);
#pragma unroll
        for (int ai = 0; ai < 2; ++ai)
#pragma unroll
            for (int m = 0; m < 4; ++m) { const int rl = rl0 + ai * HALF + m; const float c = rs[u.pm * BM + rl] * (1.0f / W8_SCALE);
                const f32x4 pq = *(const LAS f32x4*)(xch + rl * 4); const float rstd = rsqrtf(((pq[0] + pq[1]) + (pq[2] + pq[3])) * (1.0f / 128.0f) + RMS_EPS) * c;
                const f32x4 v0 = acc[ai][0][m][0] * (rstd * KSC_) * g0, v1 = acc[ai][0][m][1] * (rstd * KSC_) * g1;
                u32x2 w; w.x = cvt_pk4_fp8(v0[0], v0[1], v0[2], v0[3]); w.y = cvt_pk4_fp8(v1[0], v1[1], v1[2], v1[3]);
                *(u32x2*)(K8 + (size_t)(u.pm * BM + rl) * 2048 + u.pn * 128 + kpos) = w; }
        const int t0 = u.pm * BM, bb = t0 / SEQ, tile0 = (t0 % SEQ) / 64 + wr;
#pragma unroll
        for (int ai = 0; ai < 2; ++ai) { unsigned char* tb = V8T + ((size_t)((bb * NH + u.pn) * (SEQ / 64) + tile0 + 2 * ai)) * 8192 + 4 * ((fr >> 1) & 3);
            const f32x4 c4 = *(const f32x4*)(rs + u.pm * BM + rl0 + ai * HALF) * (1.0f / W8_SCALE);
#pragma unroll
            for (int e = 0; e < 8; ++e) { const int D = dl0 + e, ch = 2 * (fr & 1) + (fr >> 3);
                const unsigned w = cvt_pk4_fp8(acc[ai][1][0][e >> 2][e & 3] * c4[0], acc[ai][1][1][e >> 2][e & 3] * c4[1], acc[ai][1][2][e >> 2][e & 3] * c4[2], acc[ai][1][3][e >> 2][e & 3] * c4[3]);
                *(unsigned*)(tb + D * 64 + (((ch ^ (D >> 2)) & 3) << 4)) = w; } }
        asm volatile("s_waitcnt lgkmcnt(0)" ::: "memory"); __builtin_amdgcn_s_barrier(); asm volatile("" ::: "memory");
    }
};
struct EpiPool {
    static constexpr bool PERM = true; static constexpr bool PERMA = false;
    bf16_t* O; const bf16_t* Z; const bf16_t* YA; const float* s_pool;
    __device__ __forceinline__ void operator()(const f32x4 (&acc)[2][2][4][2], const Unit& u, int wr, int wc, int fr, int fq) const {
        const int row0 = u.pm * BM + wr * 64 + fr, col0 = u.pn * BM + wc * 32 + 8 * fq;
        f32x4 sv[2][2];
#pragma unroll
        for (int bj = 0; bj < 2; ++bj)
#pragma unroll
            for (int n = 0; n < 2; ++n) sv[bj][n] = *(const f32x4*)(s_pool + col0 + bj * HALF + 4 * n);
#pragma unroll
        for (int ai = 0; ai < 2; ++ai)
#pragma unroll
            for (int m = 0; m < 4; ++m) { const size_t r = (size_t)(row0 + ai * HALF + m * 16); bf16_t* rowp = O + r * DM + col0; const bf16_t* zr = Z + r * ZLD + col0; const bf16_t* yr = YA + r * DM + col0;
#pragma unroll
                for (int bj = 0; bj < 2; ++bj) { const u32x4 g = *(const u32x4*)(zr + ZO_GP + bj * HALF), a = *(const u32x4*)(zr + ZO_GA + bj * HALF), y = *(const u32x4*)(yr + bj * HALF);
                    const f32x4 v0 = acc[ai][bj][m][0] * sv[bj][0], v1 = acc[ai][bj][m][1] * sv[bj][1];
                    u32x4 w;
                    w.x = cvt_pk_bf16(v0[0] * sigmoidf_(bf_lo(g.x)) + sigmoidf_(bf_lo(a.x)) * bf_lo(y.x), v0[1] * sigmoidf_(bf_hi(g.x)) + sigmoidf_(bf_hi(a.x)) * bf_hi(y.x));
                    w.y = cvt_pk_bf16(v0[2] * sigmoidf_(bf_lo(g.y)) + sigmoidf_(bf_lo(a.y)) * bf_lo(y.y), v0[3] * sigmoidf_(bf_hi(g.y)) + sigmoidf_(bf_hi(a.y)) * bf_hi(y.y));
                    w.z = cvt_pk_bf16(v1[0] * sigmoidf_(bf_lo(g.z)) + sigmoidf_(bf_lo(a.z)) * bf_lo(y.z), v1[1] * sigmoidf_(bf_hi(g.z)) + sigmoidf_(bf_hi(a.z)) * bf_hi(y.z));
                    w.w = cvt_pk_bf16(v1[2] * sigmoidf_(bf_lo(g.w)) + sigmoidf_(bf_lo(a.w)) * bf_lo(y.w), v1[3] * sigmoidf_(bf_hi(g.w)) + sigmoidf_(bf_hi(a.w)) * bf_hi(y.w));
                    *(u32x4*)(rowp + bj * HALF) = w; } }
    }
};
struct EpiOut {
    static constexpr bool PERM = true; static constexpr bool PERMA = false;
    const float* base; bf16_t* C; unsigned char* H2; const float* g;
    __device__ __forceinline__ void operator()(const f32x4 (&acc)[2][2][4][2], const Unit& u, int wr, int wc, int fr, int fq) const {
        const int row0 = u.pm * BM + wr * 64 + fr, col0 = u.pn * BM + wc * 32 + 8 * fq;
        f32x4 gv[2][2];
#pragma unroll
        for (int bj = 0; bj < 2; ++bj)
#pragma unroll
            for (int n = 0; n < 2; ++n) gv[bj][n] = *(const f32x4*)(g + col0 + bj * HALF + 4 * n);
#pragma unroll
        for (int ai = 0; ai < 2; ++ai)
#pragma unroll
            for (int m = 0; m < 4; ++m) { const size_t off = (size_t)(row0 + ai * HALF + m * 16) * DM + col0;
#pragma unroll
                for (int bj = 0; bj < 2; ++bj) { const f32x4 v0 = *(const f32x4*)(base + off + bj * HALF) + acc[ai][bj][m][0], v1 = *(const f32x4*)(base + off + bj * HALF + 4) + acc[ai][bj][m][1];
                    { u32x4 xw; xw.x = cvt_pk_bf16(v0[0], v0[1]); xw.y = cvt_pk_bf16(v0[2], v0[3]); xw.z = cvt_pk_bf16(v1[0], v1[1]); xw.w = cvt_pk_bf16(v1[2], v1[3]); *(u32x4*)(C + off + bj * HALF) = xw; }
                    const f32x4 h0 = v0 * gv[bj][0], h1 = v1 * gv[bj][1];
                    u32x2 w; w.x = cvt_pk4_fp8(h0[0], h0[1], h0[2], h0[3]); w.y = cvt_pk4_fp8(h1[0], h1[1], h1[2], h1[3]);
                    *(u32x2*)(H2 + off + bj * HALF) = w; } }
    }
};
struct EpiSwiglu {
    static constexpr bool PERM = true; static constexpr bool PERMA = false;
    unsigned char* O; const float* bgu; const float* rs;
    __device__ __forceinline__ void operator()(const f32x4 (&acc)[2][2][4][2], const Unit& u, int wr, int wc, int fr, int fq) const {
        const int row0 = u.pm * BM + wr * 64 + fr, j0 = u.pn * HALF + wc * 32 + 8 * fq;
        const float* bg = bgu + (size_t)u.e * 2 * DFF + j0;
        f32x4 bgv[2], buv[2];
#pragma unroll
        for (int n = 0; n < 2; ++n) { bgv[n] = *(const f32x4*)(bg + 4 * n); buv[n] = *(const f32x4*)(bg + DFF + 4 * n); }
        constexpr float inv = 1.0f / W8_SCALE;
#pragma unroll
        for (int ai = 0; ai < 2; ++ai)
#pragma unroll
            for (int m = 0; m < 4; ++m) { const int r = row0 + ai * HALF + m * 16; unsigned char* rowp = O + (size_t)r * DFF + j0; const float sc = inv * rs[(size_t)u.e * XCAP + u.lr0 + (r - u.pm * BM)];
                float a[8];
#pragma unroll
                for (int n = 0; n < 2; ++n)
#pragma unroll
                    for (int h = 0; h < 2; ++h) {
                        const f32x2 ag = {acc[ai][0][m][n][2 * h], acc[ai][0][m][n][2 * h + 1]}, au = {acc[ai][1][m][n][2 * h], acc[ai][1][m][n][2 * h + 1]};
                        const f32x2 bg2 = {bgv[n][2 * h], bgv[n][2 * h + 1]}, bu2 = {buv[n][2 * h], buv[n][2 * h + 1]};
                        f32x2 g = ag * sc + bg2, up = au * sc + bu2;
                        g.x = fminf(g.x, 7.0f); g.y = fminf(g.y, 7.0f);
                        up.x = __builtin_amdgcn_fmed3f(up.x, -7.0f, 7.0f); up.y = __builtin_amdgcn_fmed3f(up.y, -7.0f, 7.0f);
                        const f32x2 t = g * (-1.702f * 1.4426950408889634f);
                        f32x2 e; e.x = __builtin_amdgcn_exp2f(t.x); e.y = __builtin_amdgcn_exp2f(t.y);
                        const f32x2 d = e + 1.0f;
                        f32x2 rr; rr.x = __builtin_amdgcn_rcpf(d.x); rr.y = __builtin_amdgcn_rcpf(d.y);
                        const f32x2 o2 = (up * ACT8_SCALE + ACT8_SCALE) * (g * rr);
                        a[4 * n + 2 * h] = o2.x; a[4 * n + 2 * h + 1] = o2.y; }
                u32x2 w; w.x = cvt_pk4_fp8(a[0], a[1], a[2], a[3]); w.y = cvt_pk4_fp8(a[4], a[5], a[6], a[7]);
                *(u32x2*)rowp = w; }
    }
};
struct EpiDown {
    static constexpr bool PERM = true; static constexpr bool PERMA = false;
    unsigned char* O; const float* bd; const float* row_w;
    __device__ __forceinline__ void operator()(const f32x4 (&acc)[2][2][4][2], const Unit& u, int wr, int wc, int fr, int fq) const {
        const int row0 = u.pm * BM + wr * 64 + fr, col0 = u.pn * BM + wc * 32 + 8 * fq;
        const float* b = bd + (size_t)u.e * DM + col0;
        f32x4 bv[2][2];
#pragma unroll
        for (int bj = 0; bj < 2; ++bj)
#pragma unroll
            for (int n = 0; n < 2; ++n) bv[bj][n] = *(const f32x4*)(b + bj * HALF + 4 * n);
#pragma unroll
        for (int ai = 0; ai < 2; ++ai)
#pragma unroll
            for (int m = 0; m < 4; ++m) { const int r = row0 + ai * HALF + m * 16; const float rw = row_w[(size_t)u.e * XCAP + u.lr0 + (r - u.pm * BM)] * Y8_SCALE; unsigned char* rowp = O + (size_t)r * DM + col0;
#pragma unroll
                for (int bj = 0; bj < 2; ++bj) { const f32x4 v0 = (acc[ai][bj][m][0] * (1.0f / (W8_SCALE * ACT8_SCALE)) + bv[bj][0]) * rw, v1 = (acc[ai][bj][m][1] * (1.0f / (W8_SCALE * ACT8_SCALE)) + bv[bj][1]) * rw;
                    u32x2 w; w.x = cvt_pk4_fp8(v0[0], v0[1], v0[2], v0[3]); w.y = cvt_pk4_fp8(v1[0], v1[1], v1[2], v1[3]);
                    *(u32x2*)(rowp + bj * HALF) = w; } }
    }
};

template <bool FP8 = false, class Epi, class Sched>
__device__ __forceinline__ void gemm_phase(LAS unsigned char* lds, const int K, const int lda, const int ldb, const Sched& S, const Epi& E, const int wid) {
    const int lane = lane_id(), tid = wid * 64 + lane, wr = wid >> 2, wc = wid & 3, fr = lane & 15, fq = lane >> 4;
    const int nt = K / BK;
    unsigned voffA[2], voffB[2];
#pragma unroll
    for (int i = 0; i < 2; ++i) { int R, C; stage_rc(tid * 16 + i * 8192, R, C); const int Rb = Epi::PERM ? ((R & ~31) + perm32(R & 31)) : R;
        const int Ra = Epi::PERMA ? ((R & ~63) + 4 * (R & 15) + ((R >> 4) & 3)) : R;
        voffA[i] = (unsigned)(Ra * lda + C) * 2u; voffB[i] = (unsigned)(Rb * ldb + C) * 2u; }
    const size_t kstep = (size_t)(BK * 2);
    const size_t hstepA = (size_t)HALF * lda * 2, hstepB = (size_t)HALF * ldb * 2;
    const unsigned ldsb = (unsigned)(uintptr_t)lds + (unsigned)wid * 1024u;
    const int aoff = lds_byte(wr * 64 + fr, fq * 8), boff = lds_byte(wc * 32 + fr, fq * 8);
#define PG8_SA(b, h) (((b) * 2 + (h)) * HTB)
#define PG8_SB(b, h) ((4 + (b) * 2 + (h)) * HTB)
#define PG8_STAGE(bufoff, gbase, voff) do { _Pragma("unroll") for (int _i = 0; _i < 2; ++_i) { unsigned keep_; \
        asm volatile("s_mov_b32 %0, m0\n\ts_mov_b32 m0, %3\n\ts_nop 0\n\tglobal_load_lds_dwordx4 %1, %2\n\ts_mov_b32 m0, %0" : "=&s"(keep_) : "v"((voff)[_i]), "s"(gbase), "s"(ldsb + (unsigned)((bufoff) + _i * 8192)) : "memory"); } } while (0)
#define PG8_LD8(addr) __builtin_shufflevector(*(const LAS i32x4*)(addr), *(const LAS i32x4*)((addr) + 1024), 0, 1, 2, 3, 4, 5, 6, 7)
#define PG8_LDA(dst, b, h) do { _Pragma("unroll") for (int m = 0; m < 4; ++m) dst[m] = PG8_LD8(lds + PG8_SA(b, h) + aoff + m * 2048); } while (0)
#define PG8_LDB(dst, b, h) do { _Pragma("unroll") for (int n = 0; n < 2; ++n) dst[n] = PG8_LD8(lds + PG8_SB(b, h) + boff + n * 2048); } while (0)
#define PG8_LO(x) __builtin_bit_cast(bf16x8, __builtin_shufflevector((x), (x), 0, 1, 2, 3))
#define PG8_HI(x) __builtin_bit_cast(bf16x8, __builtin_shufflevector((x), (x), 4, 5, 6, 7))
#define PG8_MMA(ai, bj, At, Bt) do { __builtin_amdgcn_s_setprio(1); _Pragma("unroll") for (int m = 0; m < 4; ++m) _Pragma("unroll") for (int n = 0; n < 2; ++n) { \
        if constexpr (FP8) acc[ai][bj][m][n] = __builtin_amdgcn_mfma_scale_f32_16x16x128_f8f6f4(Bt[n], At[m], acc[ai][bj][m][n], 0, 0, 0, 0, 0, 0); \
        else { acc[ai][bj][m][n] = __builtin_amdgcn_mfma_f32_16x16x32_bf16(PG8_LO(Bt[n]), PG8_LO(At[m]), acc[ai][bj][m][n], 0, 0, 0); \
               acc[ai][bj][m][n] = __builtin_amdgcn_mfma_f32_16x16x32_bf16(PG8_HI(Bt[n]), PG8_HI(At[m]), acc[ai][bj][m][n], 0, 0, 0); } } \
        __builtin_amdgcn_s_setprio(0); } while (0)
#define PG8_WAIT_V(n) asm volatile("s_waitcnt vmcnt(" #n ")" ::: "memory")
#define PG8_WAIT_L(n) asm volatile("s_waitcnt lgkmcnt(" #n ")" ::: "memory")
#define PG8_BAR __builtin_amdgcn_s_barrier()
#define PG8_SCHED __builtin_amdgcn_sched_barrier(0)
    Unit cur, nxt; int ui = 0;
    if (!S.next(0, cur)) return;
    f32x4 acc[2][2][4][2];
#pragma unroll
    for (int a = 0; a < 2; ++a)
#pragma unroll
        for (int b = 0; b < 2; ++b)
#pragma unroll
            for (int m = 0; m < 4; ++m)
#pragma unroll
                for (int n = 0; n < 2; ++n) acc[a][b][m][n] = (f32x4){0.f, 0.f, 0.f, 0.f};
    i32x8 At[4], B0[2], B1[2];
    const char* cA = cur.A; const char* cB = cur.B;
    PG8_STAGE(PG8_SB(0, 0), cB, voffB); PG8_STAGE(PG8_SB(0, 1), cB + hstepB, voffB); PG8_STAGE(PG8_SA(0, 0), cA, voffA); PG8_STAGE(PG8_SA(0, 1), cA + hstepA, voffA);
    if (wr == 1) PG8_BAR;
    PG8_WAIT_V(2); PG8_BAR;
    PG8_STAGE(PG8_SB(1, 0), cB + kstep, voffB); PG8_STAGE(PG8_SA(1, 0), cA + kstep, voffA); PG8_STAGE(PG8_SB(1, 1), cB + hstepB + kstep, voffB);
    PG8_WAIT_V(6); PG8_BAR;
    for (;;) {
        const bool has_next = S.next(ui + 1, nxt);
        const char* nA = has_next ? nxt.A : cA; const char* nB = has_next ? nxt.B : cB;
#pragma unroll 1
        for (int t = 0; t < nt; t += 2) {
            const bool last = (t == nt - 2);
            const char* a1 = cA + (size_t)(t + 1) * kstep;
            const char* a2 = last ? nA : cA + (size_t)(t + 2) * kstep; const char* b2 = last ? nB : cB + (size_t)(t + 2) * kstep;
            const char* a3 = a2 + kstep; const char* b3 = b2 + kstep;
            PG8_LDB(B0, 0, 0); PG8_LDB(B1, 0, 1); PG8_SCHED; PG8_LDA(At, 0, 0); PG8_STAGE(PG8_SA(1, 1), a1 + hstepA, voffA);
            PG8_WAIT_V(8); PG8_WAIT_L(0); PG8_BAR; PG8_MMA(0, 0, At, B0); PG8_MMA(0, 1, At, B1); PG8_BAR; PG8_SCHED;
            PG8_LDA(At, 0, 1); PG8_STAGE(PG8_SB(0, 0), b2, voffB); PG8_STAGE(PG8_SB(0, 1), b2 + hstepB, voffB); PG8_STAGE(PG8_SA(0, 0), a2, voffA);
            PG8_WAIT_V(8); PG8_WAIT_L(0); PG8_BAR; PG8_MMA(1, 0, At, B0); PG8_MMA(1, 1, At, B1); PG8_BAR; PG8_SCHED;
            PG8_LDB(B0, 1, 0); PG8_LDB(B1, 1, 1); PG8_SCHED; PG8_LDA(At, 1, 0); PG8_STAGE(PG8_SA(0, 1), a2 + hstepA, voffA);
            PG8_WAIT_V(8); PG8_WAIT_L(0); PG8_BAR; PG8_MMA(0, 0, At, B0); PG8_MMA(0, 1, At, B1); PG8_BAR; PG8_SCHED;
            PG8_LDA(At, 1, 1); PG8_STAGE(PG8_SB(1, 0), b3, voffB); PG8_STAGE(PG8_SB(1, 1), b3 + hstepB, voffB); PG8_STAGE(PG8_SA(1, 0), a3, voffA);
            PG8_WAIT_V(8); PG8_WAIT_L(0); PG8_BAR; PG8_MMA(1, 0, At, B0); PG8_MMA(1, 1, At, B1); PG8_BAR; PG8_SCHED;
        }
        if (wr == 0) PG8_BAR;
        { const int l2 = lane_id(); E(acc, cur, wr, wc, l2 & 15, l2 >> 4); }
        if (!has_next) break;
#pragma unroll
        for (int a = 0; a < 2; ++a)
#pragma unroll
            for (int b = 0; b < 2; ++b)
#pragma unroll
                for (int m = 0; m < 4; ++m)
#pragma unroll
                    for (int n = 0; n < 2; ++n) acc[a][b][m][n] = (f32x4){0.f, 0.f, 0.f, 0.f};
        cur = nxt; cA = nA; cB = nB; ++ui;
        if (wr == 1) PG8_BAR;
    }
    PG8_WAIT_V(0);
    PG8_BAR;
#undef PG8_SA
#undef PG8_SB
#undef PG8_STAGE
#undef PG8_LDA
#undef PG8_LDB
#undef PG8_MMA
#undef PG8_LO
#undef PG8_HI
#undef PG8_LD8
#undef PG8_WAIT_V
#undef PG8_WAIT_L
#undef PG8_BAR
#undef PG8_SCHED
}
}

namespace att {
constexpr int NW = 8, QBLK = 32, KVBLK = 64, QB = NW * QBLK;
constexpr int QS = 3072, K8S = 2048, KP8S = 64, OS = 2048;
constexpr int STG = 20480, NSTG = 6, SOFF_K = 0, SOFF_V = 12288;
constexpr int OFF_WS = NSTG * STG;
constexpr int LDS_BYTES = OFF_WS + NW * 64 * 4;
constexpr float SCALE = 0.07216878364870322f;
constexpr float QSC = 0.25f, KSC = 1.4426950408889634f * SCALE / QSC;
constexpr float THR = 3.f, PLOG2 = 4.f;
#ifndef ATT_NQR
#define ATT_NQR 4
#endif
constexpr int NQR = ATT_NQR;
constexpr int WBIG = 0x40000000;
static_assert(LDS_BYTES <= RING_BYTES, "attention LDS");

#define K8SW(key, c) ((key) * 64 + ((((c) ^ ((key) >> 2)) & 3) << 4))
#define SBAR() __builtin_amdgcn_sched_barrier(0)
__device__ __forceinline__ int crow(int r, int hi) { return (r & 3) + 8 * (r >> 2) + 4 * hi; }
__device__ __forceinline__ bf16x8 load8(const bf16_t* p) { return *reinterpret_cast<const bf16x8*>(p); }
__device__ __forceinline__ void mask_tile(f32x16& p0, f32x16& p1, int dq, unsigned W) {
    const float NEG = -__builtin_inff();
#pragma unroll
    for (int r = 0; r < 16; ++r) {
        const int c = (r & 3) + 8 * (r >> 2);
        if ((unsigned)(dq - c) >= W) p0[r] = NEG;
        if ((unsigned)(dq - c - 32) >= W) p1[r] = NEG;
    }
}
template <bool FIRST>
__device__ __forceinline__ bool partialSM(f32x16& p0, f32x16& p1, float& M, f32x16& minit, float& alpha) {
    float tmax = p0[0]; for (int r = 1; r < 16; ++r) tmax = fmaxf(tmax, p0[r]); for (int r = 0; r < 16; ++r) tmax = fmaxf(tmax, p1[r]);
    { auto rr = __builtin_amdgcn_permlane32_swap(__float_as_uint(tmax), __float_as_uint(tmax), false, false);
      tmax = fmaxf(__uint_as_float(rr[0]), __uint_as_float(rr[1])); }
    const float d0 = tmax - PLOG2;
    const bool moved = FIRST || !__all(d0 <= THR * 1.4426950408889634f);
    if (__builtin_expect(moved, FIRST)) {
        const float d = FIRST ? d0 : fmaxf(d0, 0.f);
        alpha = __builtin_amdgcn_exp2f(-d); M += d;
        for (int r = 0; r < 16; ++r) { p0[r] -= d; p1[r] -= d; }
        const float mi = PLOG2 - M;
        for (int r = 0; r < 16; ++r) minit[r] = mi;
    } else alpha = 1.f;
    for (int r = 0; r < 16; ++r) p0[r] = __builtin_amdgcn_exp2f(p0[r]);
    return moved;
}
__device__ __forceinline__ void finishSM(f32x16& p0, f32x16& p1, i32x8& pa) {
    for (int r = 0; r < 16; ++r) p1[r] = __builtin_amdgcn_exp2f(p1[r]);
#pragma unroll
    for (int v = 0; v < 4; ++v) { pa[v] = (int)cvt_pk4_fp8(p0[4 * v], p0[4 * v + 1], p0[4 * v + 2], p0[4 * v + 3]); pa[4 + v] = (int)cvt_pk4_fp8(p1[4 * v], p1[4 * v + 1], p1[4 * v + 2], p1[4 * v + 3]); }
}
__device__ __forceinline__ void qkt(f32x16& p0, f32x16& p1, const char* stg, int ka, const i32x8* qf, const f32x16& minit) {
    p0 = minit; p1 = minit;
#pragma unroll
    for (int s = 0; s < 3; ++s) { const char* a = stg + SOFF_K + s * 4096 + ka; const char* b = stg + SOFF_K + s * 4096 + (ka ^ 16);
        const i32x4 a0 = *reinterpret_cast<const i32x4*>(a), a1 = *reinterpret_cast<const i32x4*>(b);
        const i32x4 c0 = *reinterpret_cast<const i32x4*>(a + 2048), c1 = *reinterpret_cast<const i32x4*>(b + 2048);
        p0 = __builtin_amdgcn_mfma_scale_f32_32x32x64_f8f6f4(__builtin_shufflevector(a0, a1, 0, 1, 2, 3, 4, 5, 6, 7), qf[s], p0, 0, 0, 0, 0, 0, 0);
        p1 = __builtin_amdgcn_mfma_scale_f32_32x32x64_f8f6f4(__builtin_shufflevector(c0, c1, 0, 1, 2, 3, 4, 5, 6, 7), qf[s], p1, 0, 0, 0, 0, 0, 0); }
}
__device__ __forceinline__ void v_read(i32x8 (&vf)[4], const char* stg, int ka) {
#pragma unroll
    for (int d0 = 0; d0 < 4; ++d0) { const i32x4 a0 = *reinterpret_cast<const i32x4*>(stg + SOFF_V + d0 * 2048 + ka), a1 = *reinterpret_cast<const i32x4*>(stg + SOFF_V + d0 * 2048 + (ka ^ 16));
        vf[d0] = __builtin_shufflevector(a0, a1, 0, 1, 2, 3, 4, 5, 6, 7); }
}
__device__ __forceinline__ void pv_mma(f32x16* o, f32x16& ol, const i32x8 (&vf)[4], const i32x8 ones, const i32x8 pa) {
#pragma unroll
    for (int d0 = 0; d0 < 4; ++d0) o[d0] = __builtin_amdgcn_mfma_scale_f32_32x32x64_f8f6f4(pa, vf[d0], o[d0], 0, 0, 0, 0, 0, 0);
    ol = __builtin_amdgcn_mfma_scale_f32_32x32x64_f8f6f4(pa, ones, ol, 0, 0, 0, 0, 0, 0);
}
struct BlockRef { const bf16_t* Q; const unsigned char* V8; const unsigned char* K8; const unsigned char* KP; bf16_t* O; int P0, tok0; };
struct Seam { bf16x8 qr[NQR]; int g; };
typedef const GAS char* gptr;
__device__ __forceinline__ gptr uni(const GAS void* p) { const unsigned long long v = (unsigned long long)p; const unsigned lo = __builtin_amdgcn_readfirstlane((unsigned)v), hi = __builtin_amdgcn_readfirstlane((unsigned)(v >> 32)); return (gptr)(((unsigned long long)hi << 32) | lo); }
__device__ __forceinline__ bf16x8 ldu(gptr ubase, unsigned voff) { return *reinterpret_cast<const GAS bf16x8*>(ubase + voff); }
#define VMW() asm volatile("s_waitcnt vmcnt(0)" ::: "memory")
#define VMWN(n) asm volatile("s_waitcnt vmcnt(%0)" :: "i"(n) : "memory")
#define ATT_DMA(ldsaddr, gbase, voff) do { unsigned keep_; asm volatile("s_mov_b32 %0, m0\n\ts_mov_b32 m0, %3\n\ts_nop 0\n\tglobal_load_lds_dwordx4 %1, %2\n\ts_mov_b32 m0, %0" : "=&s"(keep_) : "v"(voff), "s"(gbase), "s"(ldsaddr) : "memory"); } while (0)
#define DMA_SETUP() const unsigned ldsw = (unsigned)__builtin_amdgcn_readfirstlane((int)(unsigned)(uintptr_t)lds) + (unsigned)wid * 1024u;                                              \
    const unsigned voff_v8 = (unsigned)tid * 16u, voff_kn = (unsigned)(((tid >> 2) & 63) * K8S + (tid >> 8) * 64 + (((tid & 3) ^ (tid >> 4)) & 3) * 16),                                  \
                   voff_kp = (unsigned)(((tid >> 2) & 63) * KP8S + (((tid & 3) ^ (tid >> 4)) & 3) * 16)
#define DMA_TILE(st, v8b, k8b, kpb) do { const unsigned sb_ = ldsw + (unsigned)(st) * (unsigned)STG; ATT_DMA(sb_ + SOFF_K, (k8b), voff_kn); ATT_DMA(sb_ + SOFF_V, (v8b), voff_v8);   \
        if (wid < 4) ATT_DMA(sb_ + SOFF_K + 8192, (kpb), voff_kp); } while (0)
#define DMA_WAIT1() do { if (wid < 4) VMWN(3); else VMWN(2); } while (0)
#define QLOAD(ref) do { gptr qb_ = uni((const GAS void*)((ref).Q + (size_t)(wid * QBLK) * QS)); _Pragma("unroll") for (int d0 = 0; d0 < NQR; ++d0) S.qr[d0] = ldu(qb_ + d0 * 32, voff_q); } while (0)
#define QPLOAD(ref) do { gptr qb_ = uni((const GAS void*)((ref).Q + (size_t)(wid * QBLK) * QS)); _Pragma("unroll") for (int d0 = NQR; d0 < 12; ++d0) q12[d0] = ldu(qb_ + d0 * 32, voff_q); } while (0)
struct QNorm { const float* CS; const float* gqn; const float* gqr; };
__device__ __forceinline__ void unpk8(bf16x8 x, float (&v)[8]) { const u32x4 w = __builtin_bit_cast(u32x4, x);
    v[0] = bf_lo(w.x); v[1] = bf_hi(w.x); v[2] = bf_lo(w.y); v[3] = bf_hi(w.y); v[4] = bf_lo(w.z); v[5] = bf_hi(w.z); v[6] = bf_lo(w.w); v[7] = bf_hi(w.w); }
__device__ __forceinline__ bf16x8 pk8(const float (&v)[8]) { u32x4 w; w.x = cvt_pk_bf16(v[0], v[1]); w.y = cvt_pk_bf16(v[2], v[3]); w.z = cvt_pk_bf16(v[4], v[5]); w.w = cvt_pk_bf16(v[6], v[7]); return __builtin_bit_cast(bf16x8, w); }
struct QCoef { f32x4 c[4], s[4], ga[4], gb[4]; };
__device__ __forceinline__ void qcoef_load(QCoef& C, const QNorm& N, int tok, int hi) {
#pragma unroll
    for (int f = 0; f < 2; ++f) { const int i0 = f * 16 + hi * 8; const float* cp = N.CS + (size_t)tok * 64 + i0; const float* g = N.gqr + i0;
#pragma unroll
        for (int j = 0; j < 2; ++j) { C.c[2 * f + j] = *(const f32x4*)(cp + 4 * j); C.s[2 * f + j] = *(const f32x4*)(cp + 32 + 4 * j); C.ga[2 * f + j] = *(const f32x4*)(g + 4 * j); C.gb[2 * f + j] = *(const f32x4*)(g + 32 + 4 * j); } }
}
__device__ __forceinline__ void qnorm_rope(const bf16x8 (&q)[12], const QCoef& C, i32x8 (&qf)[3]) {
    float sn = 0.f, sp = 0.f, v[8];
#pragma unroll
    for (int f = 0; f < 8; ++f) { unpk8(q[f], v);
#pragma unroll
        for (int e = 0; e < 8; ++e) sn += v[e] * v[e]; }
#pragma unroll
    for (int f = 8; f < 12; ++f) { unpk8(q[f], v);
#pragma unroll
        for (int e = 0; e < 8; ++e) sp += v[e] * v[e]; }
    { auto rr = __builtin_amdgcn_permlane32_swap(__float_as_uint(sn), __float_as_uint(sn), false, false); sn = __uint_as_float(rr[0]) + __uint_as_float(rr[1]); }
    { auto rr = __builtin_amdgcn_permlane32_swap(__float_as_uint(sp), __float_as_uint(sp), false, false); sp = __uint_as_float(rr[0]) + __uint_as_float(rr[1]); }
    const float rn = rsqrtf(sn * (1.f / 128.f) + RMS_EPS), rp = rsqrtf(sp * (1.f / 64.f) + RMS_EPS);
#pragma unroll
    for (int f = 0; f < 8; ++f) { unpk8(q[f], v);
#pragma unroll
        for (int e = 0; e < 8; ++e) v[e] *= rn * QSC;
        qf[f >> 2][2 * (f & 3)] = (int)cvt_pk4_fp8(v[0], v[1], v[2], v[3]); qf[f >> 2][2 * (f & 3) + 1] = (int)cvt_pk4_fp8(v[4], v[5], v[6], v[7]); }
#pragma unroll
    for (int f = 0; f < 2; ++f) {
        float t1[8], t2[8], o1[8], o2[8]; unpk8(q[8 + f], t1); unpk8(q[10 + f], t2);
#pragma unroll
        for (int e = 0; e < 8; ++e) { const int j = 2 * f + (e >> 2), k = e & 3; const float a = t1[e] * (rp * QSC) * C.ga[j][k], b = t2[e] * (rp * QSC) * C.gb[j][k]; o1[e] = a * C.c[j][k] - b * C.s[j][k]; o2[e] = b * C.c[j][k] + a * C.s[j][k]; }
        qf[2][2 * f] = (int)cvt_pk4_fp8(o1[0], o1[1], o1[2], o1[3]); qf[2][2 * f + 1] = (int)cvt_pk4_fp8(o1[4], o1[5], o1[6], o1[7]);
        qf[2][4 + 2 * f] = (int)cvt_pk4_fp8(o2[0], o2[1], o2[2], o2[3]); qf[2][5 + 2 * f] = (int)cvt_pk4_fp8(o2[4], o2[5], o2[6], o2[7]); }
}
__device__ __forceinline__ void prime(const BlockRef& cur, char* lds, Seam& S, const int wid) {
    const int lane = lane_id(), tid = wid * 64 + lane, r32 = lane & 31, hi = lane >> 5;
    DMA_SETUP();
    const unsigned voff_q = (unsigned)(r32 * QS + hi * 8) * 2u;
    QLOAD(cur);
    gptr V8h = uni((const GAS void*)cur.V8); gptr K8h = uni((const GAS void*)cur.K8); gptr KPh = uni((const GAS void*)cur.KP);
    DMA_TILE(0, V8h, K8h, KPh); DMA_TILE(1, V8h + 8192, K8h + KVBLK * K8S, KPh + KVBLK * KP8S);
    S.g = 0;
}
template <int AV>
__device__ __forceinline__ void block(const BlockRef& cur, const BlockRef& nxt, char* lds, Seam& S, const int wid, const QNorm& QN) {
    const int lane = lane_id(), tid = wid * 64 + lane, r32 = lane & 31, hi = lane >> 5;
    const int NT = (cur.P0 + QB - 1) / KVBLK + 1;
    const int qlo = cur.P0 + wid * QBLK, qm = qlo + r32 - 4 * hi;
    float* ws = (float*)(lds + OFF_WS) + wid * 64; float* al_l = ws + 32;
    float m_reg = 0.f; f32x16 o[4] = {}, ol = {}, minit;
#pragma unroll
    for (int r = 0; r < 16; ++r) minit[r] = PLOG2;
    i32x8 ones;
#pragma unroll
    for (int i = 0; i < 8; ++i) ones[i] = 0x38383838;
    asm volatile("" : "+v"(ones));
    DMA_SETUP();
    const unsigned voff_q = (unsigned)(r32 * QS + hi * 8) * 2u;
    const int ka = K8SW(r32, 2 * hi);
    const int g = __builtin_amdgcn_readfirstlane(S.g);
    gptr V8h = uni((const GAS void*)cur.V8); gptr K8h = uni((const GAS void*)cur.K8); gptr KPh = uni((const GAS void*)cur.KP);
    gptr nV8h = uni((const GAS void*)nxt.V8); gptr nK8h = uni((const GAS void*)nxt.K8); gptr nKPh = uni((const GAS void*)nxt.KP);
#define RESC(a) do { { if (hi == 0) al_l[r32] = (a); asm volatile("s_waitcnt lgkmcnt(0)" ::: "memory");                                  \
                     for (int d_ = 0; d_ < 4; ++d_) for (int r = 0; r < 16; ++r) o[d_][r] *= al_l[crow(r, hi)];                           \
                     for (int r = 0; r < 16; ++r) ol[r] *= al_l[crow(r, hi)]; } } while (0)
#define KBASE(t) ((t) * KVBLK)
#define INC6(x, k) (((x) + (k)) >= NSTG ? ((x) + (k) - NSTG) : ((x) + (k)))
#define STGP(st) (lds + (st) * STG)
#define ISSUE(tn, stn) do { const int tn_ = (tn); const bool in_ = tn_ < NT; const int tt_ = in_ ? tn_ : tn_ - NT;                                               \
        DMA_TILE((stn), uni((in_ ? V8h : nV8h) + (size_t)tt_ * 8192), uni((in_ ? K8h : nK8h) + (size_t)tt_ * (KVBLK * K8S)), uni((in_ ? KPh : nKPh) + (size_t)tt_ * (KVBLK * KP8S))); } while (0)
#define MASKT(P0_, P1_, t) do { const int kb_ = KBASE(t); if (kb_ + KVBLK - 1 > qlo) mask_tile(P0_, P1_, qm - kb_, (unsigned)WBIG); } while (0)
    f32x16 pA0, pA1, pB0, pB1; float mnA, mnB, alA, alB; i32x8 pa, vf[4];
    bf16x8 q12[12]; QPLOAD(cur); QCoef qc_; qcoef_load(qc_, QN, cur.tok0 + wid * QBLK + r32, hi); SBAR();
    VMW(); __syncthreads();
    if (!(AV & 8)) { ISSUE(2, INC6(g, 2)); ISSUE(3, INC6(g, 3)); }
    { _Pragma("unroll") for (int d0 = 0; d0 < NQR; ++d0) q12[d0] = S.qr[d0]; }
    i32x8 qf[3];
    qnorm_rope(q12, qc_, qf);
    SBAR(); qkt(pA0, pA1, STGP(g), ka, qf, minit);
    MASKT(pA0, pA1, 0); (void)partialSM<true>(pA0, pA1, m_reg, minit, alA);
#define STEP(PX0, PX1, mnX, alX, PY0, PY1, alY, t, stx, stv) do {                                                             \
        SBAR();                                                                                                               \
        if (!(AV & 2)) qkt(PX0, PX1, STGP(stx), ka, qf, minit); else { _Pragma("unroll") for (int r_ = 0; r_ < 16; ++r_) { PX0[r_] = __int_as_float(qf[0][r_ & 7]) + PX0[r_]; PX1[r_] = __int_as_float(qf[1][r_ & 7]) + PX1[r_]; } } \
        if (!(AV & 1)) finishSM(PY0, PY1, pa); else { _Pragma("unroll") for (int v_ = 0; v_ < 8; ++v_) pa[v_] = __float_as_int(PY0[v_]) ^ __float_as_int(PY1[v_ + 8]); }  SBAR();   \
        if (!(AV & 2)) { v_read(vf, STGP(stv), ka); pv_mma(o, ol, vf, ones, pa); } else { _Pragma("unroll") for (int r_ = 0; r_ < 16; ++r_) { o[0][r_] += __int_as_float(pa[r_ & 7]); ol[r_] += 1.f; } }                \
        if (!(AV & 1)) { MASKT(PX0, PX1, (t)); if (partialSM<false>(PX0, PX1, m_reg, minit, alX)) RESC(alX); } } while (0)
    int sc = INC6(g, 1);
    if (wid < 4) __builtin_amdgcn_s_setprio(1);
    STEP(pB0, pB1, mnB, alB, pA0, pA1, alA, 1, sc, g);
    for (int t = 2; t < NT; t += 2) {
        const int sp = sc, s0 = INC6(sc, 1), s1 = INC6(sc, 2), s2 = INC6(sc, 3), s3 = INC6(sc, 4);
        VMW(); if (!(AV & 4)) __syncthreads(); if (!(AV & 8)) { ISSUE(t + 2, s2); ISSUE(t + 3, s3); }
        STEP(pA0, pA1, mnA, alA, pB0, pB1, alB, t, s0, sp);
        STEP(pB0, pB1, mnB, alB, pA0, pA1, alA, t + 1, s1, s0);
        sc = s1;
    }
    SBAR(); QLOAD(nxt); v_read(vf, STGP(sc), ka); SBAR();
    finishSM(pB0, pB1, pa); SBAR();
    pv_mma(o, ol, vf, ones, pa);
    S.g = INC6(sc, 1);
    __builtin_amdgcn_s_setprio(0);
    float rli[16];
#pragma unroll
    for (int r = 0; r < 16; ++r) rli[r] = __builtin_amdgcn_rcpf(ol[r]);
    GAS char* Ow = (GAS char*)uni((const GAS void*)(cur.O + (size_t)(wid * QBLK) * OS));
    const bool odd = (r32 & 1) != 0;
    const unsigned voff_o = (unsigned)((4 * hi + (odd ? 1 : 0)) * OS + (r32 & ~1)) * 2u;
#pragma unroll
    for (int r = 0; r < 16; r += 2) { const int orow0 = (r & 3) + 8 * (r >> 2);
#pragma unroll
        for (int d0 = 0; d0 < 4; ++d0) { const float a = o[d0][r] * rli[r], b = o[d0][r + 1] * rli[r + 1];
            const float send = odd ? a : b;
            const float recv = __int_as_float(__builtin_amdgcn_mov_dpp(__float_as_int(send), 0xB1, 0xF, 0xF, true));
            *(GAS unsigned*)(Ow + (size_t)orow0 * OS * 2 + d0 * 64 + voff_o) = cvt_pk_bf16(odd ? recv : a, odd ? b : recv); } }
    __syncthreads();
#undef RESC
#undef KBASE
#undef STGP
#undef INC6
#undef ISSUE
#undef MASKT
#undef STEP
}
#undef QLOAD
#undef QPLOAD
#undef QPWRITE
constexpr int NQB = SEQ / QB, NX = NQB / 2, NITEMS = 2 * NH * NX;
struct Item { int bh, qb0, qb1; };
__device__ __forceinline__ Item decode(int L) {
    const int xcd = L & 7, k = L >> 3; Item it; it.bh = (k / NX) * 8 + xcd; const int x = k % NX; it.qb0 = x; it.qb1 = NQB - 1 - x; return it;
}
__device__ __forceinline__ BlockRef mkref(const Item& it, int pass, const bf16_t* Q, const unsigned char* V8T, const unsigned char* K8, const unsigned char* KPE, bf16_t* O) {
    const int qb = pass ? it.qb1 : it.qb0, b = it.bh / NH, h = it.bh % NH;
    BlockRef r; const size_t t0 = (size_t)b * SEQ;
    r.Q = Q + (t0 + (size_t)qb * QB) * QS + h * 192; r.O = O + (t0 + (size_t)qb * QB) * OS + h * 128;
    r.V8 = V8T + (size_t)it.bh * (SEQ / 64) * 8192; r.K8 = K8 + t0 * K8S + h * 128; r.KP = KPE + t0 * KP8S; r.P0 = qb * QB; r.tok0 = (int)t0 + qb * QB;
    return r;
}
template <int PSEL, int AV = 0>
__device__ __forceinline__ void attn_phase(char* lds, const bf16_t* Q, const unsigned char* KV, const unsigned char* K8, const unsigned char* KPE, bf16_t* O, int G, int c, const int wid, const QNorm& QN) {
    int L = c; if (L >= NITEMS) return;
    Item it = decode(L); int pass = PSEL < 0 ? 0 : PSEL;
    BlockRef cur = mkref(it, pass, Q, KV, K8, KPE, O);
    Seam S;
    prime(cur, lds, S, wid);
    for (;;) {
        const bool more_pass = PSEL < 0 && pass == 0, more_item = L + G < NITEMS, last = !more_pass && !more_item;
        Item itn = it; int passn = pass + 1, Ln = L;
        if (!more_pass) { passn = PSEL < 0 ? 0 : PSEL; Ln = more_item ? L + G : L; itn = decode(Ln); }
        const BlockRef nxt = last ? cur : mkref(itn, passn, Q, KV, K8, KPE, O);
        block<AV>(cur, nxt, lds, S, wid, QN);
        if (last) break;
        cur = nxt; it = itn; pass = passn; L = Ln;
    }
    VMW(); __syncthreads();
}
#undef VMW
#undef VMWN
#undef ATT_DMA
#undef DMA_SETUP
#undef DMA_TILE
#undef DMA_WAIT1
}

struct Params { const float* in[22]; float* out; unsigned char* ws; int ph_lo, ph_hi; };
enum { I_X = 0, I_POS, I_GMIX, I_WIN, I_GQL, I_WUQ, I_GKVL, I_WUKV, I_GQN, I_GQR, I_GKN, I_GKR, I_WPOOL, I_SPOOL, I_WOUT, I_GFFN, I_WR, I_BR, I_WGU, I_BGU, I_WD, I_BD };

__device__ __forceinline__ void transpose_item(const float* W, int N, int k0, int n0, bf16_t* WT, int ldk, int dst_row0, LAS float* scr, int lane, const float* kgain) {
    float v[32];
#pragma unroll
    for (int i = 0; i < 32; ++i) v[i] = W[(size_t)(k0 + 2 * i + (lane >> 5)) * N + n0 + (lane & 31)];
    if (kgain) {
#pragma unroll
        for (int i = 0; i < 32; ++i) v[i] *= kgain[k0 + 2 * i + (lane >> 5)]; }
#pragma unroll
    for (int i = 0; i < 32; ++i) { const int kk = 2 * i + (lane >> 5); scr[kk * 32 + ((lane & 31) ^ ((kk >> 3) << 2))] = v[i]; }
    LDS_WAIT(); asm volatile("" ::: "memory");
    const int c = lane & 7;
#pragma unroll
    for (int j = 0; j < 4; ++j) { const int n = (lane >> 3) + 8 * j; const LAS float* s = scr + (8 * c) * 32 + (n ^ (c << 2));
        u32x4 o; o.x = cvt_pk_bf16(s[0 * 32], s[1 * 32]); o.y = cvt_pk_bf16(s[2 * 32], s[3 * 32]); o.z = cvt_pk_bf16(s[4 * 32], s[5 * 32]); o.w = cvt_pk_bf16(s[6 * 32], s[7 * 32]);
        *(u32x4*)(WT + (size_t)(dst_row0 + n) * ldk + k0 + 8 * c) = o; }
    LDS_WAIT(); asm volatile("" ::: "memory");
}

__device__ __forceinline__ void transpose_item_fp8(const float* W, int N, int k0, int n0, unsigned char* WT, int ldk, int dst_row0, LAS float* scr, int lane, const float* kgain) {
    float v[64];
#pragma unroll
    for (int i = 0; i < 64; ++i) v[i] = W[(size_t)(k0 + 2 * i + (lane >> 5)) * N + n0 + (lane & 31)];
#pragma unroll
    for (int i = 0; i < 64; ++i) { const int kk = 2 * i + (lane >> 5); scr[kk * 32 + ((lane & 31) ^ ((kk >> 4) << 2))] = v[i] * W8_SCALE; }
    LDS_WAIT(); asm volatile("" ::: "memory");
    const int c = lane & 7;
    f32x4 g[4];
#pragma unroll
    for (int q = 0; q < 4; ++q) g[q] = kgain ? *(const f32x4*)(kgain + k0 + 16 * c + 4 * q) : (f32x4){1.f, 1.f, 1.f, 1.f};
#pragma unroll
    for (int j = 0; j < 4; ++j) { const int n = (lane >> 3) + 8 * j; const LAS float* s = scr + (16 * c) * 32 + (n ^ (c << 2));
        u32x4 o; o.x = cvt_pk4_fp8(s[0 * 32] * g[0][0], s[1 * 32] * g[0][1], s[2 * 32] * g[0][2], s[3 * 32] * g[0][3]); o.y = cvt_pk4_fp8(s[4 * 32] * g[1][0], s[5 * 32] * g[1][1], s[6 * 32] * g[1][2], s[7 * 32] * g[1][3]);
        o.z = cvt_pk4_fp8(s[8 * 32] * g[2][0], s[9 * 32] * g[2][1], s[10 * 32] * g[2][2], s[11 * 32] * g[2][3]); o.w = cvt_pk4_fp8(s[12 * 32] * g[3][0], s[13 * 32] * g[3][1], s[14 * 32] * g[3][2], s[15 * 32] * g[3][3]);
        *(u32x4*)(WT + (size_t)(dst_row0 + n) * ldk + k0 + 16 * c) = o; }
    LDS_WAIT(); asm volatile("" ::: "memory");
}

typedef const GAS char* cgptr;
__device__ __forceinline__ cgptr cuni(const void* p) { const unsigned long long v = (unsigned long long)p; const unsigned lo = __builtin_amdgcn_readfirstlane((unsigned)v), hi = __builtin_amdgcn_readfirstlane((unsigned)(v >> 32)); return (cgptr)(((unsigned long long)hi << 32) | lo); }
struct ConvItem { cgptr src; cgptr dstp; unsigned N4; };
__device__ __forceinline__ ConvItem conv_decode(int it, const float* wgu, const float* wd, unsigned char* WguT, unsigned char* WdT) {
    constexpr int I_GU = NE * 16 * 128;
    ConvItem c; int r = it, nbn, N; const float* src; unsigned char* dstp; bool gu;
    if (r < I_GU) { const int e = r / (16 * 128); r -= e * (16 * 128); N = 4096; nbn = 128; src = wgu + (size_t)e * DM * 4096; dstp = WguT + (size_t)e * 4096 * DM; gu = true; }
    else { r -= I_GU; const int e = r / (16 * 64); r -= e * (16 * 64); N = DM; nbn = 64; src = wd + (size_t)e * DFF * DM; dstp = WdT + (size_t)e * DM * DFF; gu = false; }
    const int kb = r / nbn, nb = r - kb * nbn, n0 = nb * 32, k0 = kb * 128; int dst = n0;
    if (gu) { const int j = n0 & 2047; dst = (j >> 7) * 256 + (j & 127) + ((n0 >= 2048) ? 128 : 0); }
    c.src = cuni(src + (size_t)k0 * N + n0); c.dstp = cuni(dstp + (size_t)dst * DM + k0); c.N4 = (unsigned)N * 4u;
    return c;
}
#define CONV_LOAD(v, c) do { const unsigned lo_ = (unsigned)(lane >> 3) * (c).N4 + 16u * (unsigned)(lane & 7); _Pragma("unroll") for (int i = 0; i < 16; ++i) v[i] = __builtin_nontemporal_load((const GAS f32x4*)(cuni((const void*)((c).src + (size_t)(8 * i) * (c).N4)) + lo_)); } while (0)
#define CONV_STORE(v, c) do { _Pragma("unroll") for (int i = 0; i < 16; ++i) { const int kk_ = 8 * i + (lane >> 3); *(LAS f32x4*)(scr + kk_ * 32 + ((4 * (lane & 7)) ^ ((kk_ >> 4) << 2))) = v[i] * W8_SCALE; }     \
        LDS_WAIT(); asm volatile("" ::: "memory"); const int ch_ = lane & 7; const unsigned so_ = (unsigned)(lane >> 3) * (unsigned)DM + 16u * (unsigned)ch_;                          \
        _Pragma("unroll") for (int j = 0; j < 4; ++j) { const int n = (lane >> 3) + 8 * j; const LAS float* s_ = scr + (16 * ch_) * 32 + (n ^ (ch_ << 2));                       \
            u32x4 o; o.x = cvt_pk4_fp8(s_[0 * 32], s_[1 * 32], s_[2 * 32], s_[3 * 32]); o.y = cvt_pk4_fp8(s_[4 * 32], s_[5 * 32], s_[6 * 32], s_[7 * 32]);                     \
            o.z = cvt_pk4_fp8(s_[8 * 32], s_[9 * 32], s_[10 * 32], s_[11 * 32]); o.w = cvt_pk4_fp8(s_[12 * 32], s_[13 * 32], s_[14 * 32], s_[15 * 32]);                       \
            __builtin_nontemporal_store(o, (GAS u32x4*)((GAS char*)cuni((const void*)((c).dstp + (size_t)(8 * j) * DM)) + so_)); }                                                                    \
        LDS_WAIT(); asm volatile("" ::: "memory"); } while (0)
__device__ __forceinline__ void convert_expert_weights(const float* wgu, const float* wd, unsigned char* WguT, unsigned char* WdT, LAS float* scr, int gw, int NGW, int lane) {
    constexpr int NIT = NE * 16 * 128 + NE * 16 * 64;
    int it = gw; if (it >= NIT) return;
    f32x4 va[16], vb[16];
    ConvItem ca = conv_decode(it, wgu, wd, WguT, WdT), cb = ca;
    CONV_LOAD(va, ca);
    for (;;) {
        const bool hb = it + NGW < NIT; cb = conv_decode(hb ? it + NGW : it, wgu, wd, WguT, WdT); CONV_LOAD(vb, cb);
        CONV_STORE(va, ca);
        if (!hb) break;
        it += NGW;
        const bool ha = it + NGW < NIT; ca = conv_decode(ha ? it + NGW : it, wgu, wd, WguT, WdT); CONV_LOAD(va, ca);
        CONV_STORE(vb, cb);
        if (!ha) break;
        it += NGW;
    }
}
#undef CONV_LOAD
#undef CONV_STORE

__device__ __forceinline__ void moe_tables(const unsigned* cnt, LAS int* ts, const int tid) {
    if (tid < NE) ts[64 + tid] = (int)__hip_atomic_load(cnt + tid, RLX_AGENT);
    __syncthreads();
    if (tid == 0) { int acc = 0;
        for (int e = 0; e < NE; ++e) { ts[e] = acc; acc += (ts[64 + e] + 255) >> 8; }
        ts[NE] = acc < MT_MAX ? acc : MT_MAX; }
    __syncthreads();
}

__global__ void __launch_bounds__(512, 2) fwd_kernel(Params p) {
    extern __shared__ __attribute__((aligned(16))) unsigned char lds_raw[];
    LAS unsigned char* lds = (LAS unsigned char*)lds_raw;
    volatile LAS unsigned* MISC = (volatile LAS unsigned*)(lds + MISC_OFF);
    const int wave = __builtin_amdgcn_readfirstlane((int)threadIdx.x >> 6);
#define LANE_TID() const int lane = lane_id(), tid = wave * 64 + lane
    const int G = gridDim.x, bx = blockIdx.x;
    const int vcu = (G % 8 == 0) ? (bx % 8) * (G / 8) + bx / 8 : bx;
    unsigned char* ws = p.ws;
    unsigned* ctl = (unsigned*)(ws + WS_CTL);
    { LANE_TID(); for (int u = tid; u < 1024; u += 512) MISC[u] = 0u; }
    __syncthreads();
    XcdBarrier bar; bar.bar = ctl + CW_BAR; bar.x = 0; bar.st = nullptr;
    if (N_LAUNCHES == 1) bar = xcd_barrier_post(ctl + CW_BAR, MISC + 8, wave == 0 && lane_id() == 0);
#define GRID_BAR() do { if (N_LAUNCHES == 1) xcd_barrier(bar, wave == 0 && lane_id() == 0); } while (0)
    const int lo = (N_LAUNCHES == 1 && PROBE_PHASE < 0) ? 0 : p.ph_lo, hi = (N_LAUNCHES == 1 && PROBE_PHASE < 0) ? NPH : p.ph_hi;
#define IN(k) (lo <= (k) && (k) < hi)
#define BOTH(k) (IN(k) && IN((k) + 1))
    const int gw = vcu * 8 + wave, NGW = G * 8, NGT = G * 512;
#define GT() (vcu * 512 + tid)

    bf16_t* WinT = (bf16_t*)(ws + WS_WIN + 16 * MiB); bf16_t* WuqT = (bf16_t*)(ws + WS_WUQ); bf16_t* WukvT = (bf16_t*)(ws + WS_WUKV); bf16_t* WpoolT = (bf16_t*)(ws + WS_WPOOL);
    bf16_t* WoutT = (bf16_t*)(ws + WS_WOUT); float* WrT = (float*)(ws + WS_WRT); unsigned char* WguT = ws + WS_WGU; unsigned char* WdT = ws + WS_WD;
    bf16_t* Hb = (bf16_t*)(ws + WS_H); bf16_t* Zb = (bf16_t*)(ws + WS_Z); bf16_t* NQ = (bf16_t*)(ws + WS_NQ); bf16_t* NKV = (bf16_t*)(ws + WS_NKV);
    unsigned char* KPE8 = ws + WS_KPE; unsigned char* K8b = ws + WS_NQ; unsigned char* V8T = ws + WS_KV; unsigned char* Z8 = ws + WS_KV + 64 * MiB;
    bf16_t* POOLED = (bf16_t*)(ws + WS_POOLED); bf16_t* Qb = (bf16_t*)(ws + WS_Q); bf16_t* KVb = (bf16_t*)(ws + WS_KV);
    bf16_t* YP = (bf16_t*)(ws + WS_YP); bf16_t* YA = (bf16_t*)(ws + WS_YA); bf16_t* MERGED = (bf16_t*)(ws + WS_MERGED); unsigned char* H2 = ws + WS_H2;
    unsigned char* H8 = ws + WS_H8; unsigned char* Win8 = ws + WS_WIN; unsigned char* XS = ws + WS_XSP; unsigned char* ACT = ws + WS_ACT; unsigned char* Yb = ws + WS_Y;
    int* tok_e = (int*)(ws + WS_ROUTE); float* tok_w = (float*)(ws + WS_ROUTE + 256 * 1024); int* tok_rank = (int*)(ws + WS_ROUTE + 512 * 1024); int* tok_pos = (int*)(ws + WS_ROUTE + 768 * 1024);
    float* row_w = (float*)(ws + WS_ROWT); float* CS = (float*)(ws + WS_CS);
    float* RSQ = (float*)(ws + WS_ROUTE + 1536 * 1024); float* RSKV = (float*)(ws + WS_ROUTE + 1600 * 1024);
    float* RS2 = (float*)(ws + WS_ROUTE + 1664 * 1024); float* row_rs = (float*)(ws + WS_ROWT + 2 * MiB);
    bf16_t* X1 = (bf16_t*)(ws + WS_X1);

    if (IN(0)) { LANE_TID();
        LAS float* scr = (LAS float*)(lds + wave * 16896);
        constexpr int I_IN = 32 * 34, I_IN8 = 16 * 160, I_UQ = 4 * 96, I_UKV = 4 * 128, I_PL = 4 * 4 * 16, I_OUT = 32 * 64;
        constexpr int NITEMS = I_IN + I_IN8 + I_UQ + I_UKV + I_PL + I_OUT;
        for (int it = gw; it < NITEMS; it += NGW) {
            int r = it, idx, N, nbn, ldk; size_t soff = 0, doff; bool f8 = false;
            if (r < I_IN) { idx = I_WIN; N = 6208; nbn = 34; ldk = DM; soff = 1024; doff = WS_WKR; }
            else if ((r -= I_IN) < I_IN8) { idx = I_WIN; N = 6208; nbn = 160; ldk = DM; doff = WS_WIN; f8 = true; }
            else if ((r -= I_IN8) < I_UQ) { idx = I_WUQ; N = 3072; nbn = 96; ldk = 512; doff = WS_WUQ; f8 = true; }
            else if ((r -= I_UQ) < I_UKV) { idx = I_WUKV; N = 4096; nbn = 128; ldk = 512; doff = WS_WUKV; f8 = true; }
            else if ((r -= I_UKV) < I_PL) { const int g = r / 64; r -= g * 64; idx = I_WPOOL; N = 512; nbn = 16; ldk = 256; soff = (size_t)g * 256 * 512; doff = WS_WPOOL + (size_t)g * 512 * 256 * 2; }
            else { r -= I_PL; idx = I_WOUT; N = DM; nbn = 64; ldk = DM; doff = WS_WOUT; }
            const int kb = r / nbn, nb = r - kb * nbn, n0 = nb * 32;
            int dst = n0;
            if (idx == I_WIN && f8 && n0 >= 1024) soff = 1088;
            if (idx == I_WIN && !f8 && n0 >= 64) { dst = n0 - 64; doff = WS_WIN + 16 * MiB; }
            const float* src = p.in[idx] + soff;
            if (f8) transpose_item_fp8(src, N, kb * 128, n0, ws + doff, ldk, dst, scr, lane, idx == I_WUQ ? p.in[I_GQL] : (idx == I_WUKV ? p.in[I_GKVL] : nullptr));
            else transpose_item(src, N, kb * 64, n0, (bf16_t*)(ws + doff), ldk, dst, scr, lane, nullptr);
        }
        for (int i = GT(); i < NE * DM; i += NGT) { const int e = i / DM, k = i % DM; WrT[i] = p.in[I_GFFN][k] * p.in[I_WR][(size_t)k * NE + e]; }
        for (int m = gw; m < T; m += NGW) {
            const f32x4* xr = (const f32x4*)(p.in[I_X] + (size_t)m * DM) + lane; const f32x4* gr = (const f32x4*)p.in[I_GMIX] + lane;
            f32x4 v[8]; float s = 0.f;
#pragma unroll
            for (int j = 0; j < 8; ++j) { v[j] = xr[64 * j]; s += (v[j].x * v[j].x + v[j].y * v[j].y) + (v[j].z * v[j].z + v[j].w * v[j].w); }
            const float rstd = rsqrtf(wave_sum(s) * (1.f / DM) + RMS_EPS);
            u32x2* o8 = (u32x2*)(Hb + (size_t)m * DM) + lane; unsigned* o4 = (unsigned*)(H8 + (size_t)m * DM) + lane;
#pragma unroll
            for (int j = 0; j < 8; ++j) { const f32x4 g = gr[64 * j]; const f32x4 hv = v[j] * rstd * g; u32x2 w; w.x = cvt_pk_bf16(hv.x, hv.y); w.y = cvt_pk_bf16(hv.z, hv.w); o8[64 * j] = w; o4[64 * j] = cvt_pk4_fp8(hv.x, hv.y, hv.z, hv.w); }
        }
        if (BOTH(0)) GRID_BAR();
    }

    if (IN(1)) {
        { pg8::DenseOrder S; S.init((const bf16_t*)H8, DM / 2, (const bf16_t*)Win8, DM / 2, T, 5120, G, bx); pg8::EpiZ E{Zb, ZLD, 1.0f / W8_SCALE, Z8}; pg8::gemm_phase<true>(lds, DM / 2, DM / 2, DM / 2, S, E, wave); }
        { pg8::DenseOrder S; S.init(Hb, DM, WinT, DM, T, 1024, G, bx); pg8::EpiBf16 E{Zb + ZO_POOL, ZLD, 1.0f}; pg8::gemm_phase(lds, DM, DM, DM, S, E, wave); }
        if (BOTH(1)) GRID_BAR();
    }

    if (IN(2)) { LANE_TID();
        bf16_t* WkrT = (bf16_t*)(ws + WS_WKR);
        LAS float* zk = (LAS float*)lds;
        for (int blk = vcu; blk < T / 64; blk += G) {
            {
                const int tt = wave & 1, kq = wave >> 1, j = lane & 31, hh = lane >> 5;
                const bf16_t* hr = Hb + (size_t)(blk * 64 + tt * 32 + j) * DM + kq * 512 + hh * 8;
                const bf16_t* w0 = WkrT + (size_t)j * DM + kq * 512 + hh * 8; const bf16_t* w1 = w0 + (size_t)32 * DM;
                f32x16 a0 = {}, a1 = {};
                bf16x8 hb[32], b0[2][4], b1[2][4];
#pragma unroll
                for (int i = 0; i < 32; ++i) hb[i] = *(const bf16x8*)(hr + i * 16);
#pragma unroll
                for (int i = 0; i < 4; ++i) { b0[0][i] = *(const bf16x8*)(w0 + i * 16); b1[0][i] = *(const bf16x8*)(w1 + i * 16); }
#pragma unroll
                for (int ch = 0; ch < 8; ++ch) {
                    if (ch + 1 < 8) {
#pragma unroll
                        for (int i = 0; i < 4; ++i) { b0[(ch + 1) & 1][i] = *(const bf16x8*)(w0 + (ch + 1) * 64 + i * 16); b1[(ch + 1) & 1][i] = *(const bf16x8*)(w1 + (ch + 1) * 64 + i * 16); } }
#pragma unroll
                    for (int i = 0; i < 4; ++i) { a0 = __builtin_amdgcn_mfma_f32_32x32x16_bf16(b0[ch & 1][i], hb[ch * 4 + i], a0, 0, 0, 0); a1 = __builtin_amdgcn_mfma_f32_32x32x16_bf16(b1[ch & 1][i], hb[ch * 4 + i], a1, 0, 0, 0); }
                }
                LAS float* pp = zk + (kq * 64 + tt * 32 + j) * 65;
#pragma unroll
                for (int r = 0; r < 16; ++r) { const int c = (r & 3) + 8 * (r >> 2) + 4 * hh; pp[c] = a0[r]; pp[32 + c] = a1[r]; }
            }
            __syncthreads();
            const float inv_freq = powf(10000.0f, -(float)(2 * (lane & 31)) / 64.0f);
#pragma unroll 1
            for (int tl = wave * 8; tl < wave * 8 + 8; ++tl) {
                const int m = blk * 64 + tl;
                const bf16_t* zr = Zb + (size_t)m * ZLD;
                {
                    const u32x2 zq = *(const u32x2*)(Z8 + (size_t)m * 1024 + lane * 8), zkv = *(const u32x2*)(Z8 + (size_t)m * 1024 + 512 + lane * 8);
                    const f32x2 q0 = __builtin_amdgcn_cvt_pk_f32_fp8((int)zq.x, false), q1 = __builtin_amdgcn_cvt_pk_f32_fp8((int)zq.x, true), q2 = __builtin_amdgcn_cvt_pk_f32_fp8((int)zq.y, false), q3 = __builtin_amdgcn_cvt_pk_f32_fp8((int)zq.y, true);
                    const f32x2 k0 = __builtin_amdgcn_cvt_pk_f32_fp8((int)zkv.x, false), k1 = __builtin_amdgcn_cvt_pk_f32_fp8((int)zkv.x, true), k2 = __builtin_amdgcn_cvt_pk_f32_fp8((int)zkv.y, false), k3 = __builtin_amdgcn_cvt_pk_f32_fp8((int)zkv.y, true);
                    const float vq[8] = {q0.x, q0.y, q1.x, q1.y, q2.x, q2.y, q3.x, q3.y};
                    const float vk[8] = {k0.x, k0.y, k1.x, k1.y, k2.x, k2.y, k3.x, k3.y};
                    float sq = 0.f, sk = 0.f;
#pragma unroll
                    for (int q = 0; q < 8; ++q) { sq += vq[q] * vq[q]; sk += vk[q] * vk[q]; }
                    sq = wave_sum(sq); sk = wave_sum(sk);
                    if (lane == 0) { RSQ[m] = rsqrtf(sq * (1.f / 512.f) + RMS_EPS); RSKV[m] = rsqrtf(sk * (1.f / 512.f) + RMS_EPS); }
                }
                {
                    const float pos = (float)((const int*)p.in[I_POS])[m];
                    const int i = lane & 31;
                    const float ang = pos * inv_freq; float sn, cs; sincosf(ang, &sn, &cs);
                    if (lane < 32) { CS[(size_t)m * 64 + i] = cs; CS[(size_t)m * 64 + 32 + i] = sn; }
                    float z1 = 0.f, z2 = 0.f;
#pragma unroll
                    for (int q = 0; q < 4; ++q) { z1 += zk[(q * 64 + tl) * 65 + i]; z2 += zk[(q * 64 + tl) * 65 + 32 + i]; }
                    float sm = (lane < 32) ? (z1 * z1 + z2 * z2) : 0.f;
                    const float rstd = rsqrtf(wave_sum(sm) * (1.f / 64.f) + RMS_EPS);
                    const float t1 = z1 * (rstd * att::KSC) * p.in[I_GKR][i], t2 = z2 * (rstd * att::KSC) * p.in[I_GKR][32 + i];
                    const float o1 = t1 * cs - t2 * sn, o2 = t2 * cs + t1 * sn;
                    const unsigned pk = cvt_pk4_fp8(o1, o2, 0.f, 0.f);
                    const int pp1 = 32 * ((i >> 3) & 1) + 8 * (i >> 4) + (i & 7);
                    if (lane < 32) { KPE8[(size_t)m * 64 + pp1] = (unsigned char)(pk & 0xffu); KPE8[(size_t)m * 64 + pp1 + 16] = (unsigned char)((pk >> 8) & 0xffu); }
                }
            }
            __syncthreads();
        }
#define POOL_BODY(W) do { u32x4 z[15 + W];                                                                                   \
            _Pragma("unroll") for (int t = 0; t < 16; ++t) z[W - 1 + t] = *(const u32x4*)(zp + (size_t)t * ZLD);              \
            _Pragma("unroll") for (int j = 1; j < W; ++j) z[W - 1 - j] = (sp0 - j >= 0) ? *(const u32x4*)(zp - (size_t)j * ZLD) : (u32x4){0u, 0u, 0u, 0u};   \
            float a[8] = {0.f, 0.f, 0.f, 0.f, 0.f, 0.f, 0.f, 0.f};                                                           \
            _Pragma("unroll") for (int j = 1; j < W; ++j) { const u32x4 h = z[W - 1 - j]; a[0] += bf_lo(h.x); a[1] += bf_hi(h.x); a[2] += bf_lo(h.y); a[3] += bf_hi(h.y); a[4] += bf_lo(h.z); a[5] += bf_hi(h.z); a[6] += bf_lo(h.w); a[7] += bf_hi(h.w); }   \
            _Pragma("unroll") for (int t = 0; t < 16; ++t) { const u32x4 c = z[W - 1 + t];                                    \
                const float u0[8] = {bf_lo(c.x), bf_hi(c.x), bf_lo(c.y), bf_hi(c.y), bf_lo(c.z), bf_hi(c.z), bf_lo(c.w), bf_hi(c.w)};                             \
                _Pragma("unroll") for (int q = 0; q < 8; ++q) a[q] += u0[q];                                                  \
                const int cnt = (sp0 + t + 1) < W ? (sp0 + t + 1) : W; const float inv = 1.0f / (float)cnt;                   \
                u32x4 o; o.x = cvt_pk_bf16(a[0] * inv - u0[0], a[1] * inv - u0[1]); o.y = cvt_pk_bf16(a[2] * inv - u0[2], a[3] * inv - u0[3]);                     \
                o.z = cvt_pk_bf16(a[4] * inv - u0[4], a[5] * inv - u0[5]); o.w = cvt_pk_bf16(a[6] * inv - u0[6], a[7] * inv - u0[7]);                             \
                *(u32x4*)(op + (size_t)t * 1024) = o;                                                                         \
                const u32x4 l = z[t];                                       \
                a[0] -= bf_lo(l.x); a[1] -= bf_hi(l.x); a[2] -= bf_lo(l.y); a[3] -= bf_hi(l.y); a[4] -= bf_lo(l.z); a[5] -= bf_hi(l.z); a[6] -= bf_lo(l.w); a[7] -= bf_hi(l.w); } } while (0)
        for (int wv = gw; wv < (T / 32) * 4; wv += NGW) {
            const int g = wv & 3, m0 = ((wv >> 2) * 2 + (lane >> 5)) * 16, ch = g * 32 + (lane & 31), sp0 = m0 & (SEQ - 1);
            const bf16_t* zp = Zb + (size_t)m0 * ZLD + ZO_POOL + ch * 8; bf16_t* op = POOLED + (size_t)m0 * 1024 + ch * 8;
            if (g == 0) POOL_BODY(2); else if (g == 1) POOL_BODY(4); else if (g == 2) POOL_BODY(8); else POOL_BODY(16);
        }
#undef POOL_BODY
        if (BOTH(2)) GRID_BAR();
    }

    if (IN(3)) {
        { pg8::DenseOrder S; S.init((const bf16_t*)Z8, 512, WuqT, 256, T, 3072, G, bx); pg8::EpiRowScale E{Qb, 3072, RSQ}; pg8::gemm_phase<true>(lds, 256, 512, 256, S, E, wave); }
        { pg8::DenseOrder S; S.init((const bf16_t*)(Z8 + 512), 512, WukvT, 256, T, 4096, G, bx); pg8::EpiKV E{K8b, V8T, RSKV, p.in[I_GKN], p.in[I_GQN], (LAS float*)(lds + 131072)}; pg8::gemm_phase<true>(lds, 256, 512, 256, S, E, wave); }
        if (BOTH(3)) GRID_BAR();
    }


    if (IN(5)) {
        const att::QNorm QN{CS, p.in[I_GQN], p.in[I_GQR]};
        const int grp = (bx >> 3) % 5;
#define CONV_SLOT(g) do { if (grp == (g)) { const int lane = lane_id(); convert_expert_weights(p.in[I_WGU], p.in[I_WD], WguT, WdT, (LAS float*)(lds + wave * 16896), gw, NGW, lane); } __syncthreads(); } while (0)
        CONV_SLOT(0);
        att::attn_phase<0>((char*)lds_raw, Qb, V8T, K8b, KPE8, YA, 2 * G, bx, wave, QN);
        CONV_SLOT(1);
        att::attn_phase<1>((char*)lds_raw, Qb, V8T, K8b, KPE8, YA, 2 * G, bx, wave, QN);
        CONV_SLOT(2);
        att::attn_phase<0>((char*)lds_raw, Qb, V8T, K8b, KPE8, YA, 2 * G, bx + G, wave, QN);
        CONV_SLOT(3);
        att::attn_phase<1>((char*)lds_raw, Qb, V8T, K8b, KPE8, YA, 2 * G, bx + G, wave, QN);
        CONV_SLOT(4);
#undef CONV_SLOT
        if (BOTH(5)) GRID_BAR();
    }

    if (IN(6)) {
        { pg8::PoolOrder S; S.init(POOLED, 1024, WpoolT, 256, T, 2048, G, bx); pg8::EpiPool E{MERGED, Zb, YA, p.in[I_SPOOL]}; pg8::gemm_phase(lds, 256, 1024, 256, S, E, wave); }
        if (BOTH(6)) GRID_BAR();
    }

    if (IN(7)) {
        pg8::DenseOrder S; S.init(MERGED, DM, WoutT, DM, T, DM, G, bx);
        pg8::EpiOut E{p.in[I_X], X1, H2, p.in[I_GFFN]};
        pg8::gemm_phase(lds, DM, DM, DM, S, E, wave);
        if (BOTH(7)) GRID_BAR();
    }

    if (IN(8)) { LANE_TID();
        LAS float* part = (LAS float*)lds;
        LAS float* ssq = (LAS float*)(lds + 36864);
        LAS int* lrk = (LAS int*)(lds + 40960);
        LAS int* hist = (LAS int*)(lds + 53760);
        LAS int* base = (LAS int*)(lds + 54016);
        unsigned* cnt = ctl + CW_CNT;
        for (int blk = vcu; blk < T / 64; blk += G) {
            const int tt = wave & 1, kq = wave >> 1, j = lane & 31, hh = lane >> 5;
            if (tid < 32) hist[tid] = 0;
            {
                const bf16_t* xr = X1 + (size_t)(blk * 64 + tt * 32 + j) * DM + kq * 512 + hh * 4;
                const float* wr_ = WrT + (size_t)j * DM + kq * 512 + hh * 4;
                f32x16 acc = {}; float ss = 0.f;
                u32x2 xb[2][8]; f32x4 wb[2][8];
#pragma unroll
                for (int i = 0; i < 8; ++i) { xb[0][i] = *(const u32x2*)(xr + i * 8); wb[0][i] = *(const f32x4*)(wr_ + i * 8); }
#pragma unroll
                for (int ch = 0; ch < 8; ++ch) {
                    if (ch + 1 < 8) {
#pragma unroll
                        for (int i = 0; i < 8; ++i) { xb[(ch + 1) & 1][i] = *(const u32x2*)(xr + (ch + 1) * 64 + i * 8); wb[(ch + 1) & 1][i] = *(const f32x4*)(wr_ + (ch + 1) * 64 + i * 8); } }
#pragma unroll
                    for (int i = 0; i < 8; ++i) { const u32x2 xp = xb[ch & 1][i]; const f32x4 xv = {bf_lo(xp.x), bf_hi(xp.x), bf_lo(xp.y), bf_hi(xp.y)}, wv = wb[ch & 1][i];
                        acc = __builtin_amdgcn_mfma_f32_32x32x2f32(wv.x, xv.x, acc, 0, 0, 0); acc = __builtin_amdgcn_mfma_f32_32x32x2f32(wv.y, xv.y, acc, 0, 0, 0);
                        acc = __builtin_amdgcn_mfma_f32_32x32x2f32(wv.z, xv.z, acc, 0, 0, 0); acc = __builtin_amdgcn_mfma_f32_32x32x2f32(wv.w, xv.w, acc, 0, 0, 0);
                        ss += (xv.x * xv.x + xv.y * xv.y) + (xv.z * xv.z + xv.w * xv.w); }
                }
                LAS float* pp = part + ((kq * 2 + tt) * 32 + j) * 33;
#pragma unroll
                for (int r = 0; r < 16; ++r) pp[(r & 3) + 8 * (r >> 2) + 4 * hh] = acc[r];
                ssq[((kq * 2 + tt) * 32 + j) * 2 + hh] = ss;
            }
            __syncthreads();
            int te[4];
            if (tid < 64) {
                const int t2 = tid >> 5, jj = tid & 31, tok = blk * 64 + tid;
                float s = 0.f;
#pragma unroll
                for (int q = 0; q < 4; ++q) s += ssq[((q * 2 + t2) * 32 + jj) * 2] + ssq[((q * 2 + t2) * 32 + jj) * 2 + 1];
                const float rstd = rsqrtf(s * (1.f / DM) + RMS_EPS);
                RS2[tok] = rstd;
                float lgv[NE];
#pragma unroll
                for (int e = 0; e < NE; ++e) { float v = 0.f;
#pragma unroll
                    for (int q = 0; q < 4; ++q) v += part[((q * 2 + t2) * 32 + jj) * 33 + e];
                    lgv[e] = v * rstd + p.in[I_BR][e]; }
                unsigned mask = 0u; float tv[4];
#pragma unroll
                for (int k = 0; k < 4; ++k) { float best = -__builtin_inff(); int be = 0;
#pragma unroll
                    for (int e = 0; e < NE; ++e) { const bool take = !((mask >> e) & 1u) && lgv[e] > best; best = take ? lgv[e] : best; be = take ? e : be; }
                    mask |= 1u << be; tv[k] = best; te[k] = be; }
                float ex[4], sum = 0.f;
#pragma unroll
                for (int k = 0; k < 4; ++k) { ex[k] = __expf(tv[k] - tv[0]); sum += ex[k]; }
                const float inv = 1.0f / sum;
#pragma unroll
                for (int k = 0; k < 4; ++k) { lrk[tid * 4 + k] = atomicAdd((int*)&hist[te[k]], 1); tok_e[tok * 4 + k] = te[k]; tok_w[tok * 4 + k] = ex[k] * inv; }
            }
            __syncthreads();
            if (tid < 32) base[tid] = (int)__hip_atomic_fetch_add(cnt + tid, (unsigned)hist[tid], RLX_AGENT);
            __syncthreads();
            if (tid < 64) { const int tok = blk * 64 + tid; const float rsv = RS2[tok];
#pragma unroll
                for (int k = 0; k < 4; ++k) { const int rk = base[te[k]] + lrk[tid * 4 + k]; tok_rank[tok * 4 + k] = rk; lrk[tid * 4 + k] = te[k] * XCAP + rk;
                    row_w[(size_t)te[k] * XCAP + rk] = tok_w[tok * 4 + k]; row_rs[(size_t)te[k] * XCAP + rk] = rsv; } }
            __syncthreads();
            for (int q0 = wave; q0 < 256; q0 += 64) {
                u32x4 ra[8], rb[8]; int srow[8];
#pragma unroll
                for (int u = 0; u < 8; ++u) { const int q = q0 + 8 * u; srow[u] = lrk[q]; const u32x4* src = (const u32x4*)(H2 + (size_t)(blk * 64 + (q >> 2)) * DM) + lane; ra[u] = src[0]; rb[u] = src[64]; }
#pragma unroll
                for (int u = 0; u < 8; ++u) { u32x4* dst = (u32x4*)(XS + (size_t)srow[u] * DM) + lane; dst[0] = ra[u]; dst[64] = rb[u]; } }
            __syncthreads();
        }
        if (BOTH(8)) GRID_BAR();
    }

    LAS int* ts = (LAS int*)(lds + MISC_OFF + 256);

    if (IN(10)) { LANE_TID();
        moe_tables(ctl + CW_CNT, ts, tid);
        pg8::MoeOrder S; S.init(XS, 1, WguT, (size_t)4096 * DM, DM, ts, 16, G, bx);
        pg8::EpiSwiglu E{ACT, p.in[I_BGU], row_rs};
        pg8::gemm_phase<true>(lds, DM / 2, DM / 2, DM / 2, S, E, wave);
        if (BOTH(10)) GRID_BAR();
    }

    if (IN(11)) { LANE_TID();
        moe_tables(ctl + CW_CNT, ts, tid);
        pg8::MoeOrder S; S.init(ACT, 0, WdT, (size_t)DM * DFF, DFF, ts, 8, G, bx);
        pg8::EpiDown E{Yb, p.in[I_BD], row_w};
        pg8::gemm_phase<true>(lds, DFF / 2, DFF / 2, DFF / 2, S, E, wave);
        if (BOTH(11)) GRID_BAR();
    }

    if (IN(12)) { LANE_TID();
        moe_tables(ctl + CW_CNT, ts, tid);
        constexpr int NI = T * (DM / 16), UN = 4;
        for (int it0 = GT(); it0 < NI; it0 += UN * NGT) {
            int mm[UN], cc[UN], ee[UN][4], rk[UN][4]; u32x4 xa[UN], xb[UN], y[UN][4];
#pragma unroll
            for (int u = 0; u < UN; ++u) { const int it = it0 + u * NGT < NI ? it0 + u * NGT : it0; mm[u] = it >> 7; cc[u] = (it & 127) * 16;
                const i32x4 e4 = *(const i32x4*)(tok_e + mm[u] * 4), r4 = *(const i32x4*)(tok_rank + mm[u] * 4);
#pragma unroll
                for (int k = 0; k < 4; ++k) { ee[u][k] = e4[k]; rk[u][k] = r4[k]; }
                const bf16_t* xp = X1 + (size_t)mm[u] * DM + cc[u]; xa[u] = *(const u32x4*)xp; xb[u] = *(const u32x4*)(xp + 8); }
#pragma unroll
            for (int u = 0; u < UN; ++u)
#pragma unroll
                for (int k = 0; k < 4; ++k) { const int pos = ts[ee[u][k]] * 256 + rk[u][k]; y[u][k] = *(const u32x4*)(Yb + (size_t)pos * DM + cc[u]); }
#pragma unroll
            for (int u = 0; u < UN; ++u) {
                f32x4 a[4];
                a[0] = (f32x4){bf_lo(xa[u].x), bf_hi(xa[u].x), bf_lo(xa[u].y), bf_hi(xa[u].y)}; a[1] = (f32x4){bf_lo(xa[u].z), bf_hi(xa[u].z), bf_lo(xa[u].w), bf_hi(xa[u].w)};
                a[2] = (f32x4){bf_lo(xb[u].x), bf_hi(xb[u].x), bf_lo(xb[u].y), bf_hi(xb[u].y)}; a[3] = (f32x4){bf_lo(xb[u].z), bf_hi(xb[u].z), bf_lo(xb[u].w), bf_hi(xb[u].w)};
#pragma unroll
                for (int k = 0; k < 4; ++k)
#pragma unroll
                    for (int q = 0; q < 4; ++q) { const f32x2 lo = __builtin_amdgcn_cvt_pk_f32_fp8((int)y[u][k][q], false), hi = __builtin_amdgcn_cvt_pk_f32_fp8((int)y[u][k][q], true);
                        a[q].x += lo.x * (1.0f / Y8_SCALE); a[q].y += lo.y * (1.0f / Y8_SCALE); a[q].z += hi.x * (1.0f / Y8_SCALE); a[q].w += hi.y * (1.0f / Y8_SCALE); }
                if (it0 + u * NGT < NI) { float* op = p.out + (size_t)mm[u] * DM + cc[u];
#pragma unroll
                    for (int q = 0; q < 4; ++q) *(f32x4*)(op + 4 * q) = a[q]; }
            }
        }
    }
#undef IN
#undef BOTH
#undef GRID_BAR
}

#ifndef PROBE_AV
#define PROBE_AV -1
#endif
#if PROBE_AV >= 0
__global__ void __launch_bounds__(512, 2) probe_attn_kernel(Params p) {
    extern __shared__ __attribute__((aligned(16))) unsigned char lds_raw[];
    const int wave = __builtin_amdgcn_readfirstlane((int)threadIdx.x >> 6);
    const int G = gridDim.x, bx = blockIdx.x;
    unsigned char* ws = p.ws;
    const att::QNorm QN{(float*)(ws + WS_CS), p.in[I_GQN], p.in[I_GQR]};
    const bf16_t* Qb = (const bf16_t*)(ws + WS_Q); bf16_t* YA = (bf16_t*)(ws + WS_YA);
    att::attn_phase<0, PROBE_AV>((char*)lds_raw, Qb, ws + WS_KV, ws + WS_NQ, ws + WS_KPE, YA, 2 * G, bx, wave, QN);
    att::attn_phase<1, PROBE_AV>((char*)lds_raw, Qb, ws + WS_KV, ws + WS_NQ, ws + WS_KPE, YA, 2 * G, bx, wave, QN);
    att::attn_phase<0, PROBE_AV>((char*)lds_raw, Qb, ws + WS_KV, ws + WS_NQ, ws + WS_KPE, YA, 2 * G, bx + G, wave, QN);
    att::attn_phase<1, PROBE_AV>((char*)lds_raw, Qb, ws + WS_KV, ws + WS_NQ, ws + WS_KPE, YA, 2 * G, bx + G, wave, QN);
}
#endif

extern "C" void kernel_launch(void* const* d_in, const int* in_sizes, int n_in, void* d_out, int out_size, void* d_ws, size_t ws_size, hipStream_t stream) {
    static int grid = 0;
    if (grid == 0) {
        if (n_in != 22 || out_size != T * DM || ws_size < WS_END) { fprintf(stderr, "kernel_launch: unexpected shapes (n_in %d, out %d, ws %zu)\n", n_in, out_size, ws_size); grid = -1; return; }
        int dev = 0, cus = 0, per_cu = 0;
        if (hipGetDevice(&dev) != hipSuccess || hipDeviceGetAttribute(&cus, hipDeviceAttributeMultiprocessorCount, dev) != hipSuccess) { grid = -1; return; }
        if (hipFuncSetAttribute((const void*)fwd_kernel, hipFuncAttributeMaxDynamicSharedMemorySize, LDS_BYTES) != hipSuccess) { fprintf(stderr, "kernel_launch: hipFuncSetAttribute failed\n"); grid = -1; return; }
        if (hipOccupancyMaxActiveBlocksPerMultiprocessor(&per_cu, (const void*)fwd_kernel, 512, LDS_BYTES) != hipSuccess || per_cu < 1) fprintf(stderr, "kernel_launch: occupancy query reports %d\n", per_cu);
        (void)hipGetLastError();
        grid = cus;
    }
    if (grid < 0) return;
    (void)hipMemsetAsync((char*)d_ws + WS_CTL, 0, CTL_ZERO_BYTES, stream);
    Params p{};
    for (int i = 0; i < 22; ++i) p.in[i] = (const float*)d_in[i];
    p.out = (float*)d_out; p.ws = (unsigned char*)d_ws;
    for (int li = 0; li < N_LAUNCHES; ++li) {
        if (N_LAUNCHES == 1) { p.ph_lo = 0; p.ph_hi = NPH; } else { p.ph_lo = li; p.ph_hi = li + 1; }
        hipLaunchKernelGGL(fwd_kernel, dim3(grid), dim3(512), LDS_BYTES, stream, p);
    }
#if PROBE_AV >= 0
    (void)hipFuncSetAttribute((const void*)probe_attn_kernel, hipFuncAttributeMaxDynamicSharedMemorySize, LDS_BYTES);
    hipLaunchKernelGGL(probe_attn_kernel, dim3(grid), dim3(512), LDS_BYTES, stream, p);
#endif
    if (PROBE_PHASE >= 0) { p.ph_lo = PROBE_PHASE; p.ph_hi = PROBE_PHASE + 1; hipLaunchKernelGGL(fwd_kernel, dim3(grid), dim3(512), LDS_BYTES, stream, p); }
}
```

```cpp
#include <hip/hip_runtime.h>
#include <cstdio>
#include <cstdint>

#ifndef MK_N_LAUNCHES
#define MK_N_LAUNCHES 1
#endif
#ifndef PROBE_PHASE
#define PROBE_PHASE -1
#endif

#define GAS __attribute__((address_space(1)))
#define LAS __attribute__((address_space(3)))
typedef unsigned short bf16_t;
typedef short bf16x8 __attribute__((ext_vector_type(8)));
typedef short s16x4 __attribute__((ext_vector_type(4)));
typedef float f32x2 __attribute__((ext_vector_type(2)));
typedef float f32x4 __attribute__((ext_vector_type(4)));
typedef float f32x16 __attribute__((ext_vector_type(16)));
typedef unsigned u32x2 __attribute__((ext_vector_type(2)));
typedef unsigned u32x4 __attribute__((ext_vector_type(4)));
typedef int i32x4 __attribute__((ext_vector_type(4)));
typedef int i32x8 __attribute__((ext_vector_type(8)));

constexpr int T = 16384, SEQ = 8192, DM = 2048, NH = 16;
constexpr int ZW = 6144;
constexpr int ZO_Q = 0, ZO_KV = 512, ZO_GA = 1024, ZO_GP = 3072, ZO_POOL = 5120;
constexpr int ZLD = 6272;
constexpr int NE = 32, TOPK = 4, DFF = 2048;
constexpr int XCAP = 16384;
constexpr int MT_MAX = 288, MP_MAX = MT_MAX * 256;
constexpr float RMS_EPS = 1e-6f;
constexpr float W8_SCALE = 64.0f, ACT8_SCALE = 4.0f, Y8_SCALE = 16.0f;
constexpr int NPH = 13;
constexpr int N_LAUNCHES = MK_N_LAUNCHES;

constexpr size_t MiB = 1u << 20;
constexpr size_t WS_CTL = 0, CTL_ZERO_BYTES = 1 * MiB;
constexpr size_t WS_WIN = 2 * MiB, WS_WUQ = 28 * MiB, WS_WUKV = 32 * MiB, WS_WPOOL = 36 * MiB, WS_WOUT = 38 * MiB, WS_WRT = 46 * MiB;
constexpr size_t WS_WKR = 47 * MiB;
constexpr size_t WS_ROUTE = 48 * MiB;
constexpr size_t WS_CS = 50 * MiB;
constexpr size_t WS_KPE = 54 * MiB, WS_NQ = 56 * MiB, WS_NKV = 72 * MiB, WS_POOLED = 88 * MiB, WS_H = 120 * MiB, WS_YP = 184 * MiB, WS_YA = 248 * MiB;
constexpr size_t WS_MERGED = 312 * MiB, WS_H2 = 376 * MiB, WS_Q = 440 * MiB, WS_KV = 536 * MiB, WS_Z = 664 * MiB, WS_WGU = 864 * MiB, WS_WD = 1376 * MiB;
constexpr size_t WS_XS = 1632 * MiB, WS_ACT = 1920 * MiB, WS_Y = 2208 * MiB, WS_X1 = 2496 * MiB;
constexpr size_t WS_H8 = 2624 * MiB, WS_WIN8 = 2656 * MiB, WS_ROWT = 2664 * MiB, WS_XSP = 2672 * MiB, WS_END = 3696 * MiB;
constexpr int CW_TMO = 0, CW_CODE = 1, CW_BAR = 4096, CW_CNT = 8192;

constexpr int RING_BYTES = 151552;
constexpr int MISC_OFF = RING_BYTES;
constexpr int LDS_BYTES = 155648;

#define RLX_AGENT __ATOMIC_RELAXED, __HIP_MEMORY_SCOPE_AGENT
#define LDS_WAIT() asm volatile("s_waitcnt lgkmcnt(0)" ::: "memory")
#define VM_WAIT() asm volatile("s_waitcnt vmcnt(0)" ::: "memory")

__device__ __forceinline__ unsigned cvt_pk_bf16(float lo, float hi) { unsigned r; asm volatile("v_cvt_pk_bf16_f32 %0, %1, %2" : "=v"(r) : "v"(lo), "v"(hi)); return r; }
__device__ __forceinline__ unsigned cvt_pk4_fp8(float a, float b, float c, float d) { int w; asm("" : "=v"(w));     w = __builtin_amdgcn_cvt_pk_fp8_f32(a, b, w, false); w = __builtin_amdgcn_cvt_pk_fp8_f32(c, d, w, true); return (unsigned)w; }
__device__ __forceinline__ float bf_lo(unsigned w) { return __uint_as_float(w << 16); }
__device__ __forceinline__ float bf_hi(unsigned w) { return __uint_as_float(w & 0xffff0000u); }
__device__ __forceinline__ float sigmoidf_(float x) { return __builtin_amdgcn_rcpf(1.0f + __builtin_amdgcn_exp2f(-1.4426950408889634f * x)); }
__device__ __forceinline__ int lane_id() { int l; asm volatile("v_mbcnt_lo_u32_b32 %0, -1, 0\n\tv_mbcnt_hi_u32_b32 %0, -1, %0" : "=v"(l)); return l; }
__device__ __forceinline__ float wave_sum(float v) {
#pragma unroll
    for (int o = 1; o < 64; o <<= 1) v += __shfl_xor(v, o);
    return v;
}

#define XB_TMO      128
#define XB_XCNT(j)  (256  + 64 * (j))
#define XB_XSUB(j)  (1280 + 64 * (j))
#define XB_XGEN(j)  (2304 + 64 * (j))
#define XB_TOP      3328
#define XB_TOPGEN   3392
#define XCD_BAR_WORDS 3456
#define XB_SPIN_CAP (1u << 22)
__device__ __forceinline__ unsigned xb_ld(unsigned* p)              { return __hip_atomic_load(p, __ATOMIC_RELAXED, __HIP_MEMORY_SCOPE_AGENT); }
__device__ __forceinline__ unsigned xb_add(unsigned* p, unsigned v) { return __hip_atomic_fetch_add(p, v, __ATOMIC_RELAXED, __HIP_MEMORY_SCOPE_AGENT); }
__device__ __forceinline__ unsigned xb_xcc_id() { return (unsigned)__builtin_amdgcn_s_getreg((3 << 11) | 20) & 0xFu; }
#define XB_SPIN(cond, bar) do { unsigned _sp = 0; while (cond) { __builtin_amdgcn_s_sleep(1); \
    if ((++_sp & 255u) == 0u) { if (xb_ld(&(bar)[XB_TMO])) break; if (_sp > XB_SPIN_CAP) { atomicAdd(&(bar)[XB_TMO], 1u); break; } } } } while (0)
struct XcdBarrier { unsigned* bar; unsigned x; volatile LAS unsigned* st; };
__device__ __forceinline__ XcdBarrier xcd_barrier_post(unsigned* bar, volatile LAS unsigned* st, bool leader) {
    XcdBarrier b; b.bar = bar; b.x = xb_xcc_id(); b.st = st;
    if (leader) (void)xb_add(&bar[XB_XCNT(b.x)], 1u);
    return b;
}
__device__ __forceinline__ void xcd_barrier_complete(unsigned* bar, unsigned x, unsigned& nloc, unsigned& nx) {
    const unsigned G = gridDim.x * gridDim.y * gridDim.z;
    unsigned sum, cnt, mine, sp = 0u;
    for (;;) {
        sum = 0u; cnt = 0u; mine = 0u;
#pragma unroll
        for (unsigned j = 0; j < 16; ++j) { const unsigned c = xb_ld(&bar[XB_XCNT(j)]); sum += c; cnt += (c > 0u) ? 1u : 0u; mine = (j == x) ? c : mine; }
        if (sum == G) break;
        __builtin_amdgcn_s_sleep(1);
        if ((++sp & 255u) == 0u) { if (xb_ld(&bar[XB_TMO])) break; if (sp > XB_SPIN_CAP) { atomicAdd(&bar[XB_TMO], 1u); break; } }
    }
    nloc = mine > 0u ? mine : 1u; nx = cnt > 0u ? cnt : 1u;
}
__device__ __forceinline__ void xcd_barrier(const XcdBarrier& b, bool leader) {
    asm volatile("s_waitcnt vmcnt(0)" ::: "memory");
    __syncthreads();
    if (leader) {
        unsigned* bar = b.bar;
        __builtin_amdgcn_s_waitcnt(0);
        unsigned nloc = b.st[0], nx = b.st[1];
        if (nloc == 0u) { xcd_barrier_complete(bar, b.x, nloc, nx); b.st[0] = nloc; b.st[1] = nx; }
        const unsigned old = xb_add(&bar[XB_XSUB(b.x)], 1u);
        const unsigned gen = old / nloc;
        if (old + 1u == (gen + 1u) * nloc) {
            __builtin_amdgcn_fence(__ATOMIC_RELEASE, "agent");
            asm volatile("s_waitcnt vmcnt(0)" ::: "memory");
            const unsigned og = xb_add(&bar[XB_TOP], 1u);
            const unsigned tg = og / nx;
            if (og + 1u == (tg + 1u) * nx) xb_add(&bar[XB_TOPGEN], 1u);
            else XB_SPIN(xb_ld(&bar[XB_TOPGEN]) == tg, bar);
            __builtin_amdgcn_fence(__ATOMIC_ACQUIRE, "agent");
            xb_add(&bar[XB_XGEN(b.x)], 1u);
            asm volatile("s_waitcnt vmcnt(0)" ::: "memory");
        } else {
            XB_SPIN(xb_ld(&bar[XB_XGEN(b.x)]) == gen, bar);
            __builtin_amdgcn_fence(__ATOMIC_ACQUIRE, "agent");
            asm volatile("s_waitcnt vmcnt(0)" ::: "memory");
        }
    }
    __syncthreads();
}

namespace pg8 {
constexpr int BM = 256, BK = 64, HALF = 128, HTB = HALF * BK * 2, STAGE_BYTES = 8 * HTB, NXCD = 8, WGM = 8;
__host__ __device__ __forceinline__ int lds_byte(int r, int c) { const int st = (r >> 4) * 2 + (c >> 5), rr = r & 15, cc = c & 31, ob = rr * 64 + cc * 2; return st * 1024 + (ob ^ (((ob >> 9) & 1) << 5)); }
__host__ __device__ __forceinline__ void stage_rc(int b, int& R, int& C) { const int st = b / 1024, sb = b % 1024, swz = sb ^ (((sb >> 9) & 1) << 5); R = (st >> 1) * 16 + swz / 64; C = (st & 1) * 32 + (swz % 64) / 2; }
__host__ __device__ __forceinline__ int perm32(int rho) { const int n = rho >> 4, i = rho & 15; return 8 * (i >> 2) + 4 * n + (i & 3); }

struct Unit { int pm, pn, e, lr0; const char* A; const char* B; };
__device__ __forceinline__ int xcd_chunk(int L, int nwg) { const int q = nwg / NXCD, r = nwg % NXCD, xcd = L % NXCD, off = L / NXCD; return (xcd < r ? xcd * (q + 1) : r * (q + 1) + (xcd - r) * q) + off; }

struct DenseOrder {
    const char* A; const char* Bt; int lda, ldb; int nM, nN, nwg, G, c;
    __device__ __forceinline__ void init(const bf16_t* A_, int lda_, const bf16_t* Bt_, int ldb_, int M, int N, int G_, int c_) { A = (const char*)A_; Bt = (const char*)Bt_; lda = lda_; ldb = ldb_; nM = M / BM; nN = N / BM; nwg = nM * nN; G = G_; c = c_; }
    __device__ __forceinline__ bool next(int i, Unit& u) const {
        const int L = i * G + c; if (L >= nwg) return false;
        const int wgid = xcd_chunk(L, nwg);
        const int nig = WGM * nN, gid = wgid / nig, fm = gid * WGM, gsz = (nM - fm) < WGM ? (nM - fm) : WGM;
        u.pm = fm + ((wgid % nig) % gsz); u.pn = (wgid % nig) / gsz; u.e = 0; u.lr0 = 0;
        u.A = A + (size_t)u.pm * BM * lda * 2; u.B = Bt + (size_t)u.pn * BM * ldb * 2; return true;
    }
};
struct PoolOrder : DenseOrder {
    __device__ __forceinline__ bool next(int i, Unit& u) const {
        if (!DenseOrder::next(i, u)) return false;
        u.A += (size_t)(u.pn >> 1) * 256 * 2; return true;
    }
};
struct MoeOrder {
    const char* A; const char* Bt; size_t estride; const LAS int* ts; int nN, nwg, G, c, rowb, slabA;
    __device__ __forceinline__ void init(const void* A_, int slabA_, const void* Bt_, size_t estride_bytes, int rowbytes, const LAS int* ts_, int nN_, int G_, int c_) { slabA = slabA_; A = (const char*)A_; Bt = (const char*)Bt_; estride = estride_bytes; rowb = rowbytes; ts = ts_; nN = nN_; nwg = __builtin_amdgcn_readfirstlane(ts_[NE]) * nN_; G = G_; c = c_; }
    __device__ __forceinline__ bool next(int i, Unit& u) const {
        const int L = i * G + c; if (L >= nwg) return false;
        const int wgid = xcd_chunk(L, nwg);
        const int lj = lane_id() & 31;
        const unsigned long long bal = __ballot(ts[lj] * nN <= wgid);
        const int e = __builtin_popcount((unsigned)bal) - 1;
        const int t0 = __builtin_amdgcn_readfirstlane(ts[e]), mt = __builtin_amdgcn_readfirstlane(ts[e + 1]) - t0, uu = wgid - t0 * nN;
        const int lt = uu % mt; u.pm = t0 + lt; u.pn = uu / mt; u.e = e; u.lr0 = lt * BM;
        u.A = A + (slabA ? ((size_t)e * XCAP + (size_t)lt * BM) : (size_t)u.pm * BM) * rowb; u.B = Bt + (size_t)e * estride + (size_t)u.pn * BM * rowb; return true;
    }
};

struct EpiBf16 {
    static constexpr bool PERM = true; static constexpr bool PERMA = false;
    bf16_t* O; int ldc; float sc;
    __device__ __forceinline__ void operator()(const f32x4 (&acc)[2][2][4][2], const Unit& u, int wr, int wc, int fr, int fq) const {
        const int row0 = u.pm * BM + wr * 64 + fr, col0 = u.pn * BM + wc * 32 + 8 * fq;
#pragma unroll
        for (int ai = 0; ai < 2; ++ai)
#pragma unroll
            for (int m = 0; m < 4; ++m) { bf16_t* rowp = O + (size_t)(row0 + ai * HALF + m * 16) * ldc + col0;
#pragma unroll
                for (int bj = 0; bj < 2; ++bj) { const f32x4 v0 = acc[ai][bj][m][0] * sc, v1 = acc[ai][bj][m][1] * sc;
                    u32x4 w; w.x = cvt_pk_bf16(v0[0], v0[1]); w.y = cvt_pk_bf16(v0[2], v0[3]); w.z = cvt_pk_bf16(v1[0], v1[1]); w.w = cvt_pk_bf16(v1[2], v1[3]);
                    *(u32x4*)(rowp + bj * HALF) = w; } }
    }
};
struct EpiLat {
    static constexpr bool PERM = true; static constexpr bool PERMA = false;
    unsigned char* Z8; float sc;
    __device__ __forceinline__ void operator()(const f32x4 (&acc)[2][2][4][2], const Unit& u, int wr, int wc, int fr, int fq) const {
        const int row0 = u.pm * BM + wr * 64 + fr, col0 = u.pn * BM + wc * 32 + 8 * fq;
#pragma unroll
        for (int ai = 0; ai < 2; ++ai)
#pragma unroll
            for (int m = 0; m < 4; ++m) { const size_t r = (size_t)(row0 + ai * HALF + m * 16);
#pragma unroll
                for (int bj = 0; bj < 2; ++bj) { const f32x4 v0 = acc[ai][bj][m][0] * sc, v1 = acc[ai][bj][m][1] * sc;
                    u32x2 z; z.x = cvt_pk4_fp8(v0[0], v0[1], v0[2], v0[3]); z.y = cvt_pk4_fp8(v1[0], v1[1], v1[2], v1[3]); *(u32x2*)(Z8 + r * 1024 + col0 + bj * HALF) = z; } }
    }
};
struct EpiGate {
    static constexpr bool PERM = true; static constexpr bool PERMA = false;
    unsigned char* G8; float sc;
    __device__ __forceinline__ void operator()(const f32x4 (&acc)[2][2][4][2], const Unit& u, int wr, int wc, int fr, int fq) const {
        const int row0 = u.pm * BM + wr * 64 + fr, col0 = u.pn * BM + wc * 32 + 8 * fq;
#pragma unroll
        for (int ai = 0; ai < 2; ++ai)
#pragma unroll
            for (int m = 0; m < 4; ++m) { const size_t r = (size_t)(row0 + ai * HALF + m * 16);
#pragma unroll
                for (int bj = 0; bj < 2; ++bj) { const f32x4 v0 = acc[ai][bj][m][0] * sc, v1 = acc[ai][bj][m][1] * sc;
                    u32x2 w; w.x = 0u; w.y = 0u;
#pragma unroll
                    for (int e = 0; e < 4; ++e) { w.x = __builtin_amdgcn_cvt_pk_u8_f32(sigmoidf_(v0[e]) * 255.0f, e, w.x); w.y = __builtin_amdgcn_cvt_pk_u8_f32(sigmoidf_(v1[e]) * 255.0f, e, w.y); }
                    *(u32x2*)(G8 + r * 4096 + col0 + bj * HALF) = w; __builtin_amdgcn_sched_barrier(0); } }
    }
};
struct EpiRowScale {
    static constexpr bool PERM = true; static constexpr bool PERMA = false;
    unsigned char* O; int ldc; const float* rs;
    __device__ __forceinline__ void operator()(const f32x4 (&acc)[2][2][4][2], const Unit& u, int wr, int wc, int fr, int fq) const {
        const int row0 = u.pm * BM + wr * 64 + fr, col0 = u.pn * BM + wc * 32 + 8 * fq;
#pragma unroll
        for (int ai = 0; ai < 2; ++ai)
#pragma unroll
            for (int m = 0; m < 4; ++m) { const int r = row0 + ai * HALF + m * 16; const float c = rs[r] * (1.0f / W8_SCALE);     unsigned char* rowp = O + (size_t)r * ldc + col0;
#pragma unroll
                for (int bj = 0; bj < 2; ++bj) { const f32x4 v0 = acc[ai][bj][m][0] * c, v1 = acc[ai][bj][m][1] * c;
                    u32x2 w; w.x = cvt_pk4_fp8(v0[0], v0[1], v0[2], v0[3]); w.y = cvt_pk4_fp8(v1[0], v1[1], v1[2], v1[3]);
                    *(u32x2*)(rowp + bj * HALF) = w; } }
    }
};
constexpr float KSC_ = 1.4426950408889634f * 0.07216878364870322f / 0.25f;
struct EpiKV {
    static constexpr bool PERM = true; static constexpr bool PERMA = true;
    unsigned char* K8; unsigned char* V8T; const float* rs; const float* gk; const float* gq; LAS float* xch;
    __device__ __forceinline__ void operator()(const f32x4 (&acc)[2][2][4][2], const Unit& u, int wr, int wc, int fr, int fq) const {
        const int rl0 = wr * 64 + 4 * fr, dl0 = wc * 32 + 8 * fq;
#pragma unroll
        for (int ai = 0; ai < 2; ++ai)
#pragma unroll
            for (int m = 0; m < 4; ++m) { const int rl = rl0 + ai * HALF + m; const float c = rs[u.pm * BM + rl] * (1.0f / W8_SCALE);
                const f32x4 a = acc[ai][0][m][0] * c, b = acc[ai][0][m][1] * c;
                float q = (a[0] * a[0] + a[1] * a[1]) + (a[2] * a[2] + a[3] * a[3]) + (b[0] * b[0] + b[1] * b[1]) + (b[2] * b[2] + b[3] * b[3]);
                q += __shfl_xor(q, 16); q += __shfl_xor(q, 32);
                if (fq == 0) xch[rl * 4 + wc] = q; }
        asm volatile("s_waitcnt lgkmcnt(0)" ::: "memory"); __builtin_amdgcn_s_barrier(); asm volatile("" ::: "memory");
        const f32x4 g0 = *(const f32x4*)(gk + dl0) * *(const f32x4*)(gq + dl0), g1 = *(const f32x4*)(gk + dl0 + 4) * *(const f32x4*)(gq + dl0 + 4);
        const int kpos = 64 * (wc >> 1) + 32 * (fq & 1) + 8 * ((2 * wc + (fq >> 1)) & 3);
#pragma unroll
        for (int ai = 0; ai < 2; ++ai)
#pragma unroll
            for (int m = 0; m < 4; ++m) { const int rl = rl0 + ai * HALF + m; const float c = rs[u.pm * BM + rl] * (1.0f / W8_SCALE);
                const f32x4 pq = *(const LAS f32x4*)(xch + rl * 4); const float rstd = rsqrtf(((pq[0] + pq[1]) + (pq[2] + pq[3])) * (1.0f / 128.0f) + RMS_EPS) * c;
                const f32x4 v0 = acc[ai][0][m][0] * (rstd * KSC_) * g0, v1 = acc[ai][0][m][1] * (rstd * KSC_) * g1;
                u32x2 w; w.x = cvt_pk4_fp8(v0[0], v0[1], v0[2], v0[3]); w.y = cvt_pk4_fp8(v1[0], v1[1], v1[2], v1[3]);
                *(u32x2*)(K8 + (size_t)(u.pm * BM + rl) * 2048 + u.pn * 128 + kpos) = w; }
        const int t0 = u.pm * BM, bb = t0 / SEQ, tile0 = (t0 % SEQ) / 64 + wr;
#pragma unroll
        for (int ai = 0; ai < 2; ++ai) { unsigned char* tb = V8T + ((size_t)((bb * NH + u.pn) * (SEQ / 64) + tile0 + 2 * ai)) * 8192 + 4 * ((fr >> 1) & 3);
            const f32x4 c4 = *(const f32x4*)(rs + u.pm * BM + rl0 + ai * HALF) * (1.0f / W8_SCALE);
#pragma unroll
            for (int e = 0; e < 8; ++e) { const int D = dl0 + e, ch = 2 * (fr & 1) + (fr >> 3);
                const unsigned w = cvt_pk4_fp8(acc[ai][1][0][e >> 2][e & 3] * c4[0], acc[ai][1][1][e >> 2][e & 3] * c4[1], acc[ai][1][2][e >> 2][e & 3] * c4[2], acc[ai][1][3][e >> 2][e & 3] * c4[3]);
                *(unsigned*)(tb + D * 64 + (((ch ^ (D >> 2)) & 3) << 4)) = w; } }
        asm volatile("s_waitcnt lgkmcnt(0)" ::: "memory"); __builtin_amdgcn_s_barrier(); asm volatile("" ::: "memory");
    }
};
struct EpiPool {
    static constexpr bool PERM = true; static constexpr bool PERMA = false;
    bf16_t* O; const unsigned char* G8; const bf16_t* YA; const float* s_pool;
    __device__ __forceinline__ void operator()(const f32x4 (&acc)[2][2][4][2], const Unit& u, int wr, int wc, int fr, int fq) const {
        const int row0 = u.pm * BM + wr * 64 + fr, col0 = u.pn * BM + wc * 32 + 8 * fq;
#define U8F(x, k) ((float)(((x) >> (8 * (k))) & 0xffu) * (1.0f / 255.0f))
        f32x4 sv[2][2];
#pragma unroll
        for (int bj = 0; bj < 2; ++bj)
#pragma unroll
            for (int n = 0; n < 2; ++n) sv[bj][n] = *(const f32x4*)(s_pool + col0 + bj * HALF + 4 * n);
#pragma unroll
        for (int ai = 0; ai < 2; ++ai)
#pragma unroll
            for (int m = 0; m < 4; ++m) { const size_t r = (size_t)(row0 + ai * HALF + m * 16); bf16_t* rowp = O + r * DM + col0; const unsigned char* gr = G8 + r * 4096 + col0; const bf16_t* yr = YA + r * DM + col0;
#pragma unroll
                for (int bj = 0; bj < 2; ++bj) { const u32x2 g = *(const u32x2*)(gr + 2048 + bj * HALF), a = *(const u32x2*)(gr + bj * HALF); const u32x4 y = *(const u32x4*)(yr + bj * HALF);
                    const f32x4 v0 = acc[ai][bj][m][0] * sv[bj][0], v1 = acc[ai][bj][m][1] * sv[bj][1];
                    u32x4 w;
                    w.x = cvt_pk_bf16(v0[0] * U8F(g.x, 0) + U8F(a.x, 0) * bf_lo(y.x), v0[1] * U8F(g.x, 1) + U8F(a.x, 1) * bf_hi(y.x));
                    w.y = cvt_pk_bf16(v0[2] * U8F(g.x, 2) + U8F(a.x, 2) * bf_lo(y.y), v0[3] * U8F(g.x, 3) + U8F(a.x, 3) * bf_hi(y.y));
                    w.z = cvt_pk_bf16(v1[0] * U8F(g.y, 0) + U8F(a.y, 0) * bf_lo(y.z), v1[1] * U8F(g.y, 1) + U8F(a.y, 1) * bf_hi(y.z));
                    w.w = cvt_pk_bf16(v1[2] * U8F(g.y, 2) + U8F(a.y, 2) * bf_lo(y.w), v1[3] * U8F(g.y, 3) + U8F(a.y, 3) * bf_hi(y.w));
                    *(u32x4*)(rowp + bj * HALF) = w; } }
#undef U8F
    }
};
struct EpiOut {
    static constexpr bool PERM = true; static constexpr bool PERMA = false;
    const float* base; bf16_t* C; unsigned char* H2; const float* g;
    __device__ __forceinline__ void operator()(const f32x4 (&acc)[2][2][4][2], const Unit& u, int wr, int wc, int fr, int fq) const {
        const int row0 = u.pm * BM + wr * 64 + fr, col0 = u.pn * BM + wc * 32 + 8 * fq;
        f32x4 gv[2][2];
#pragma unroll
        for (int bj = 0; bj < 2; ++bj)
#pragma unroll
            for (int n = 0; n < 2; ++n) gv[bj][n] = *(const f32x4*)(g + col0 + bj * HALF + 4 * n);
#pragma unroll
        for (int ai = 0; ai < 2; ++ai)
#pragma unroll
            for (int m = 0; m < 4; ++m) { const size_t off = (size_t)(row0 + ai * HALF + m * 16) * DM + col0;
#pragma unroll
                for (int bj = 0; bj < 2; ++bj) { const f32x4 v0 = *(const f32x4*)(base + off + bj * HALF) + acc[ai][bj][m][0], v1 = *(const f32x4*)(base + off + bj * HALF + 4) + acc[ai][bj][m][1];
                    { u32x4 xw; xw.x = cvt_pk_bf16(v0[0], v0[1]); xw.y = cvt_pk_bf16(v0[2], v0[3]); xw.z = cvt_pk_bf16(v1[0], v1[1]); xw.w = cvt_pk_bf16(v1[2], v1[3]); *(u32x4*)(C + off + bj * HALF) = xw; }
                    const f32x4 h0 = v0 * gv[bj][0], h1 = v1 * gv[bj][1];
                    u32x2 w; w.x = cvt_pk4_fp8(h0[0], h0[1], h0[2], h0[3]); w.y = cvt_pk4_fp8(h1[0], h1[1], h1[2], h1[3]);
                    *(u32x2*)(H2 + off + bj * HALF) = w; } }
    }
};
struct EpiSwiglu {
    static constexpr bool PERM = true; static constexpr bool PERMA = false;
    unsigned char* O; const float* bgu; const float* rs;
    __device__ __forceinline__ void operator()(const f32x4 (&acc)[2][2][4][2], const Unit& u, int wr, int wc, int fr, int fq) const {
        const int row0 = u.pm * BM + wr * 64 + fr, j0 = u.pn * HALF + wc * 32 + 8 * fq;
        const float* bg = bgu + (size_t)u.e * 2 * DFF + j0;
        f32x4 bgv[2], buv[2];
#pragma unroll
        for (int n = 0; n < 2; ++n) { bgv[n] = *(const f32x4*)(bg + 4 * n); buv[n] = *(const f32x4*)(bg + DFF + 4 * n); }
        constexpr float inv = 1.0f / W8_SCALE;
#pragma unroll
        for (int ai = 0; ai < 2; ++ai)
#pragma unroll
            for (int m = 0; m < 4; ++m) { const int r = row0 + ai * HALF + m * 16; unsigned char* rowp = O + (size_t)r * DFF + j0; const float sc = inv * rs[(size_t)u.e * XCAP + u.lr0 + (r - u.pm * BM)];
                float a[8];
#pragma unroll
                for (int n = 0; n < 2; ++n)
#pragma unroll
                    for (int h = 0; h < 2; ++h) {
                        const f32x2 ag = {acc[ai][0][m][n][2 * h], acc[ai][0][m][n][2 * h + 1]}, au = {acc[ai][1][m][n][2 * h], acc[ai][1][m][n][2 * h + 1]};
                        const f32x2 bg2 = {bgv[n][2 * h], bgv[n][2 * h + 1]}, bu2 = {buv[n][2 * h], buv[n][2 * h + 1]};
                        f32x2 g = ag * sc + bg2, up = au * sc + bu2;
                        g.x = fminf(g.x, 7.0f); g.y = fminf(g.y, 7.0f);
                        up.x = __builtin_amdgcn_fmed3f(up.x, -7.0f, 7.0f); up.y = __builtin_amdgcn_fmed3f(up.y, -7.0f, 7.0f);
                        const f32x2 t = g * (-1.702f * 1.4426950408889634f);
                        f32x2 e; e.x = __builtin_amdgcn_exp2f(t.x); e.y = __builtin_amdgcn_exp2f(t.y);
                        const f32x2 d = e + 1.0f;
                        f32x2 rr; rr.x = __builtin_amdgcn_rcpf(d.x); rr.y = __builtin_amdgcn_rcpf(d.y);
                        const f32x2 o2 = (up * ACT8_SCALE + ACT8_SCALE) * (g * rr);
                        a[4 * n + 2 * h] = o2.x; a[4 * n + 2 * h + 1] = o2.y; }
                u32x2 w; w.x = cvt_pk4_fp8(a[0], a[1], a[2], a[3]); w.y = cvt_pk4_fp8(a[4], a[5], a[6], a[7]);
                *(u32x2*)rowp = w; }
    }
};
struct EpiDown {
    static constexpr bool PERM = true; static constexpr bool PERMA = false;
    unsigned char* O; const float* bd; const float* row_w;
    __device__ __forceinline__ void operator()(const f32x4 (&acc)[2][2][4][2], const Unit& u, int wr, int wc, int fr, int fq) const {
        const int row0 = u.pm * BM + wr * 64 + fr, col0 = u.pn * BM + wc * 32 + 8 * fq;
        const float* b = bd + (size_t)u.e * DM + col0;
        f32x4 bv[2][2];
#pragma unroll
        for (int bj = 0; bj < 2; ++bj)
#pragma unroll
            for (int n = 0; n < 2; ++n) bv[bj][n] = *(const f32x4*)(b + bj * HALF + 4 * n);
#pragma unroll
        for (int ai = 0; ai < 2; ++ai)
#pragma unroll
            for (int m = 0; m < 4; ++m) { const int r = row0 + ai * HALF + m * 16; const float rw = row_w[(size_t)u.e * XCAP + u.lr0 + (r - u.pm * BM)] * Y8_SCALE; unsigned char* rowp = O + (size_t)r * DM + col0;
#pragma unroll
                for (int bj = 0; bj < 2; ++bj) { const f32x4 v0 = (acc[ai][bj][m][0] * (1.0f / (W8_SCALE * ACT8_SCALE)) + bv[bj][0]) * rw, v1 = (acc[ai][bj][m][1] * (1.0f / (W8_SCALE * ACT8_SCALE)) + bv[bj][1]) * rw;
                    u32x2 w; w.x = cvt_pk4_fp8(v0[0], v0[1], v0[2], v0[3]); w.y = cvt_pk4_fp8(v1[0], v1[1], v1[2], v1[3]);
                    *(u32x2*)(rowp + bj * HALF) = w; } }
    }
};

template <bool FP8 = false, class Epi, class Sched>
__device__ __forceinline__ void gemm_phase(LAS unsigned char* lds, const int K, const int lda, const int ldb, const Sched& S, const Epi& E, const int wid) {
    const int lane = lane_id(), tid = wid * 64 + lane, wr = wid >> 2, wc = wid & 3, fr = lane & 15, fq = lane >> 4;
    const int nt = K / BK;
    unsigned voffA[2], voffB[2];
#pragma unroll
    for (int i = 0; i < 2; ++i) { int R, C; stage_rc(tid * 16 + i * 8192, R, C); const int Rb = Epi::PERM ? ((R & ~31) + perm32(R & 31)) : R;
        const int Ra = Epi::PERMA ? ((R & ~63) + 4 * (R & 15) + ((R >> 4) & 3)) : R;
        voffA[i] = (unsigned)(Ra * lda + C) * 2u; voffB[i] = (unsigned)(Rb * ldb + C) * 2u; }
    const size_t kstep = (size_t)(BK * 2);
    const size_t hstepA = (size_t)HALF * lda * 2, hstepB = (size_t)HALF * ldb * 2;
    const unsigned ldsb = (unsigned)(uintptr_t)lds + (unsigned)wid * 1024u;
    const int aoff = lds_byte(wr * 64 + fr, fq * 8), boff = lds_byte(wc * 32 + fr, fq * 8);
#define PG8_SA(b, h) (((b) * 2 + (h)) * HTB)
#define PG8_SB(b, h) ((4 + (b) * 2 + (h)) * HTB)
#define PG8_STAGE(bufoff, gbase, voff) do { _Pragma("unroll") for (int _i = 0; _i < 2; ++_i) { unsigned keep_; \
        asm volatile("s_mov_b32 %0, m0\n\ts_mov_b32 m0, %3\n\ts_nop 0\n\tglobal_load_lds_dwordx4 %1, %2\n\ts_mov_b32 m0, %0" : "=&s"(keep_) : "v"((voff)[_i]), "s"(gbase), "s"(ldsb + (unsigned)((bufoff) + _i * 8192)) : "memory"); } } while (0)
#define PG8_LD8(addr) __builtin_shufflevector(*(const LAS i32x4*)(addr), *(const LAS i32x4*)((addr) + 1024), 0, 1, 2, 3, 4, 5, 6, 7)
#define PG8_LDA(dst, b, h) do { _Pragma("unroll") for (int m = 0; m < 4; ++m) dst[m] = PG8_LD8(lds + PG8_SA(b, h) + aoff + m * 2048); } while (0)
#define PG8_LDB(dst, b, h) do { _Pragma("unroll") for (int n = 0; n < 2; ++n) dst[n] = PG8_LD8(lds + PG8_SB(b, h) + boff + n * 2048); } while (0)
#define PG8_LO(x) __builtin_bit_cast(bf16x8, __builtin_shufflevector((x), (x), 0, 1, 2, 3))
#define PG8_HI(x) __builtin_bit_cast(bf16x8, __builtin_shufflevector((x), (x), 4, 5, 6, 7))
#define PG8_MMA(ai, bj, At, Bt) do { __builtin_amdgcn_s_setprio(1); _Pragma("unroll") for (int m = 0; m < 4; ++m) _Pragma("unroll") for (int n = 0; n < 2; ++n) { \
        if constexpr (FP8) acc[ai][bj][m][n] = __builtin_amdgcn_mfma_scale_f32_16x16x128_f8f6f4(Bt[n], At[m], acc[ai][bj][m][n], 0, 0, 0, 0, 0, 0); \
        else { acc[ai][bj][m][n] = __builtin_amdgcn_mfma_f32_16x16x32_bf16(PG8_LO(Bt[n]), PG8_LO(At[m]), acc[ai][bj][m][n], 0, 0, 0); \
               acc[ai][bj][m][n] = __builtin_amdgcn_mfma_f32_16x16x32_bf16(PG8_HI(Bt[n]), PG8_HI(At[m]), acc[ai][bj][m][n], 0, 0, 0); } } \
        __builtin_amdgcn_s_setprio(0); } while (0)
#define PG8_WAIT_V(n) asm volatile("s_waitcnt vmcnt(" #n ")" ::: "memory")
#define PG8_WAIT_L(n) asm volatile("s_waitcnt lgkmcnt(" #n ")" ::: "memory")
#define PG8_BAR __builtin_amdgcn_s_barrier()
#define PG8_SCHED __builtin_amdgcn_sched_barrier(0)
    Unit cur, nxt; int ui = 0;
    if (!S.next(0, cur)) return;
    f32x4 acc[2][2][4][2];
#pragma unroll
    for (int a = 0; a < 2; ++a)
#pragma unroll
        for (int b = 0; b < 2; ++b)
#pragma unroll
            for (int m = 0; m < 4; ++m)
#pragma unroll
                for (int n = 0; n < 2; ++n) acc[a][b][m][n] = (f32x4){0.f, 0.f, 0.f, 0.f};
    i32x8 At[4], B0[2], B1[2];
    const char* cA = cur.A; const char* cB = cur.B;
    PG8_STAGE(PG8_SB(0, 0), cB, voffB); PG8_STAGE(PG8_SB(0, 1), cB + hstepB, voffB); PG8_STAGE(PG8_SA(0, 0), cA, voffA); PG8_STAGE(PG8_SA(0, 1), cA + hstepA, voffA);
    if (wr == 1) PG8_BAR;
    PG8_WAIT_V(2); PG8_BAR;
    PG8_STAGE(PG8_SB(1, 0), cB + kstep, voffB); PG8_STAGE(PG8_SA(1, 0), cA + kstep, voffA); PG8_STAGE(PG8_SB(1, 1), cB + hstepB + kstep, voffB);
    PG8_WAIT_V(6); PG8_BAR;
    for (;;) {
        const bool has_next = S.next(ui + 1, nxt);
        const char* nA = has_next ? nxt.A : cA; const char* nB = has_next ? nxt.B : cB;
#pragma unroll 1
        for (int t = 0; t < nt; t += 2) {
            const bool last = (t == nt - 2);
            const char* a1 = cA + (size_t)(t + 1) * kstep;
            const char* a2 = last ? nA : cA + (size_t)(t + 2) * kstep; const char* b2 = last ? nB : cB + (size_t)(t + 2) * kstep;
            const char* a3 = a2 + kstep; const char* b3 = b2 + kstep;
            PG8_LDB(B0, 0, 0); PG8_LDB(B1, 0, 1); PG8_SCHED; PG8_LDA(At, 0, 0); PG8_STAGE(PG8_SA(1, 1), a1 + hstepA, voffA);
            PG8_WAIT_V(8); PG8_WAIT_L(0); PG8_BAR; PG8_MMA(0, 0, At, B0); PG8_MMA(0, 1, At, B1); PG8_BAR; PG8_SCHED;
            PG8_LDA(At, 0, 1); PG8_STAGE(PG8_SB(0, 0), b2, voffB); PG8_STAGE(PG8_SB(0, 1), b2 + hstepB, voffB); PG8_STAGE(PG8_SA(0, 0), a2, voffA);
            PG8_WAIT_V(8); PG8_WAIT_L(0); PG8_BAR; PG8_MMA(1, 0, At, B0); PG8_MMA(1, 1, At, B1); PG8_BAR; PG8_SCHED;
            PG8_LDB(B0, 1, 0); PG8_LDB(B1, 1, 1); PG8_SCHED; PG8_LDA(At, 1, 0); PG8_STAGE(PG8_SA(0, 1), a2 + hstepA, voffA);
            PG8_WAIT_V(8); PG8_WAIT_L(0); PG8_BAR; PG8_MMA(0, 0, At, B0); PG8_MMA(0, 1, At, B1); PG8_BAR; PG8_SCHED;
            PG8_LDA(At, 1, 1); PG8_STAGE(PG8_SB(1, 0), b3, voffB); PG8_STAGE(PG8_SB(1, 1), b3 + hstepB, voffB); PG8_STAGE(PG8_SA(1, 0), a3, voffA);
            PG8_WAIT_V(8); PG8_WAIT_L(0); PG8_BAR; PG8_MMA(1, 0, At, B0); PG8_MMA(1, 1, At, B1); PG8_BAR; PG8_SCHED;
        }
        if (wr == 0) PG8_BAR;
        { const int l2 = lane_id(); E(acc, cur, wr, wc, l2 & 15, l2 >> 4); }
        if (!has_next) break;
#pragma unroll
        for (int a = 0; a < 2; ++a)
#pragma unroll
            for (int b = 0; b < 2; ++b)
#pragma unroll
                for (int m = 0; m < 4; ++m)
#pragma unroll
                    for (int n = 0; n < 2; ++n) acc[a][b][m][n] = (f32x4){0.f, 0.f, 0.f, 0.f};
        cur = nxt; cA = nA; cB = nB; ++ui;
        if (wr == 1) PG8_BAR;
    }
    PG8_WAIT_V(0);
    PG8_BAR;
#undef PG8_SA
#undef PG8_SB
#undef PG8_STAGE
#undef PG8_LDA
#undef PG8_LDB
#undef PG8_MMA
#undef PG8_LO
#undef PG8_HI
#undef PG8_LD8
#undef PG8_WAIT_V
#undef PG8_WAIT_L
#undef PG8_BAR
#undef PG8_SCHED
}
}

namespace att {
constexpr int NW = 8, QBLK = 32, KVBLK = 64, QB = NW * QBLK;
constexpr int QS = 3072, K8S = 2048, KP8S = 64, OS = 2048;
constexpr int STG = 20480, NSTG = 6, SOFF_K = 0, SOFF_V = 12288;
constexpr int OFF_WS = NSTG * STG;
constexpr int LDS_BYTES = OFF_WS + NW * 64 * 4;
constexpr float SCALE = 0.07216878364870322f;
constexpr float QSC = 0.25f, KSC = 1.4426950408889634f * SCALE / QSC;
constexpr float THR = 3.f, PLOG2 = 4.f;
#ifndef ATT_NQR
#define ATT_NQR 4
#endif
constexpr int NQR = ATT_NQR;
constexpr int WBIG = 0x40000000;
static_assert(LDS_BYTES <= RING_BYTES, "attention LDS");

#define K8SW(key, c) ((key) * 64 + ((((c) ^ ((key) >> 2)) & 3) << 4))
#define SBAR() __builtin_amdgcn_sched_barrier(0)
__device__ __forceinline__ int crow(int r, int hi) { return (r & 3) + 8 * (r >> 2) + 4 * hi; }
__device__ __forceinline__ bf16x8 load8(const bf16_t* p) { return *reinterpret_cast<const bf16x8*>(p); }
__device__ __forceinline__ void mask_tile(f32x16& p0, f32x16& p1, int dq, unsigned W) {
    const float NEG = -__builtin_inff();
#pragma unroll
    for (int r = 0; r < 16; ++r) {
        const int c = (r & 3) + 8 * (r >> 2);
        if ((unsigned)(dq - c) >= W) p0[r] = NEG;
        if ((unsigned)(dq - c - 32) >= W) p1[r] = NEG;
    }
}
template <bool FIRST>
__device__ __forceinline__ bool partialSM(f32x16& p0, f32x16& p1, float& M, f32x16& minit, float& alpha) {
    float tmax = p0[0]; for (int r = 1; r < 16; ++r) tmax = fmaxf(tmax, p0[r]); for (int r = 0; r < 16; ++r) tmax = fmaxf(tmax, p1[r]);
    { auto rr = __builtin_amdgcn_permlane32_swap(__float_as_uint(tmax), __float_as_uint(tmax), false, false);
      tmax = fmaxf(__uint_as_float(rr[0]), __uint_as_float(rr[1])); }
    const float d0 = tmax - PLOG2;
    const bool moved = FIRST || !__all(d0 <= THR * 1.4426950408889634f);
    if (__builtin_expect(moved, FIRST)) {
        const float d = FIRST ? d0 : fmaxf(d0, 0.f);
        alpha = __builtin_amdgcn_exp2f(-d); M += d;
        for (int r = 0; r < 16; ++r) { p0[r] -= d; p1[r] -= d; }
        const float mi = PLOG2 - M;
        for (int r = 0; r < 16; ++r) minit[r] = mi;
    } else alpha = 1.f;
    for (int r = 0; r < 16; ++r) p0[r] = __builtin_amdgcn_exp2f(p0[r]);
    return moved;
}
__device__ __forceinline__ void finishSM(f32x16& p0, f32x16& p1, i32x8& pa) {
    for (int r = 0; r < 16; ++r) p1[r] = __builtin_amdgcn_exp2f(p1[r]);
#pragma unroll
    for (int v = 0; v < 4; ++v) { pa[v] = (int)cvt_pk4_fp8(p0[4 * v], p0[4 * v + 1], p0[4 * v + 2], p0[4 * v + 3]); pa[4 + v] = (int)cvt_pk4_fp8(p1[4 * v], p1[4 * v + 1], p1[4 * v + 2], p1[4 * v + 3]); }
}
__device__ __forceinline__ void qkt(f32x16& p0, f32x16& p1, const char* stg, int ka, const i32x8* qf, const f32x16& minit) {
    p0 = minit; p1 = minit;
#pragma unroll
    for (int s = 0; s < 3; ++s) { const char* a = stg + SOFF_K + s * 4096 + ka; const char* b = stg + SOFF_K + s * 4096 + (ka ^ 16);
        const i32x4 a0 = *reinterpret_cast<const i32x4*>(a), a1 = *reinterpret_cast<const i32x4*>(b);
        const i32x4 c0 = *reinterpret_cast<const i32x4*>(a + 2048), c1 = *reinterpret_cast<const i32x4*>(b + 2048);
        p0 = __builtin_amdgcn_mfma_scale_f32_32x32x64_f8f6f4(__builtin_shufflevector(a0, a1, 0, 1, 2, 3, 4, 5, 6, 7), qf[s], p0, 0, 0, 0, 0, 0, 0);
        p1 = __builtin_amdgcn_mfma_scale_f32_32x32x64_f8f6f4(__builtin_shufflevector(c0, c1, 0, 1, 2, 3, 4, 5, 6, 7), qf[s], p1, 0, 0, 0, 0, 0, 0); }
}
__device__ __forceinline__ void v_read(i32x8 (&vf)[4], const char* stg, int ka) {
#pragma unroll
    for (int d0 = 0; d0 < 4; ++d0) { const i32x4 a0 = *reinterpret_cast<const i32x4*>(stg + SOFF_V + d0 * 2048 + ka), a1 = *reinterpret_cast<const i32x4*>(stg + SOFF_V + d0 * 2048 + (ka ^ 16));
        vf[d0] = __builtin_shufflevector(a0, a1, 0, 1, 2, 3, 4, 5, 6, 7); }
}
__device__ __forceinline__ void pv_mma(f32x16* o, f32x16& ol, const i32x8 (&vf)[4], const i32x8 ones, const i32x8 pa) {
#pragma unroll
    for (int d0 = 0; d0 < 4; ++d0) o[d0] = __builtin_amdgcn_mfma_scale_f32_32x32x64_f8f6f4(pa, vf[d0], o[d0], 0, 0, 0, 0, 0, 0);
    ol = __builtin_amdgcn_mfma_scale_f32_32x32x64_f8f6f4(pa, ones, ol, 0, 0, 0, 0, 0, 0);
}
struct BlockRef { const unsigned char* Q; const unsigned char* V8; const unsigned char* K8; const unsigned char* KP; bf16_t* O; int P0, tok0; };
struct Seam { u32x2 qr[NQR]; int g; };
typedef const GAS char* gptr;
__device__ __forceinline__ gptr uni(const GAS void* p) { const unsigned long long v = (unsigned long long)p; const unsigned lo = __builtin_amdgcn_readfirstlane((unsigned)v), hi = __builtin_amdgcn_readfirstlane((unsigned)(v >> 32)); return (gptr)(((unsigned long long)hi << 32) | lo); }
__device__ __forceinline__ bf16x8 ldu(gptr ubase, unsigned voff) { return *reinterpret_cast<const GAS bf16x8*>(ubase + voff); }
#define VMW() asm volatile("s_waitcnt vmcnt(0)" ::: "memory")
#define VMWN(n) asm volatile("s_waitcnt vmcnt(%0)" :: "i"(n) : "memory")
#define ATT_DMA(ldsaddr, gbase, voff) do { unsigned keep_; asm volatile("s_mov_b32 %0, m0\n\ts_mov_b32 m0, %3\n\ts_nop 0\n\tglobal_load_lds_dwordx4 %1, %2\n\ts_mov_b32 m0, %0" : "=&s"(keep_) : "v"(voff), "s"(gbase), "s"(ldsaddr) : "memory"); } while (0)
#define DMA_SETUP() const unsigned ldsw = (unsigned)__builtin_amdgcn_readfirstlane((int)(unsigned)(uintptr_t)lds) + (unsigned)wid * 1024u;                                              \
    const unsigned voff_v8 = (unsigned)tid * 16u, voff_kn = (unsigned)(((tid >> 2) & 63) * K8S + (tid >> 8) * 64 + (((tid & 3) ^ (tid >> 4)) & 3) * 16),                                  \
                   voff_kp = (unsigned)(((tid >> 2) & 63) * KP8S + (((tid & 3) ^ (tid >> 4)) & 3) * 16)
#define DMA_TILE(st, v8b, k8b, kpb) do { const unsigned sb_ = ldsw + (unsigned)(st) * (unsigned)STG; ATT_DMA(sb_ + SOFF_K, (k8b), voff_kn); ATT_DMA(sb_ + SOFF_V, (v8b), voff_v8);   \
        if (wid < 4) ATT_DMA(sb_ + SOFF_K + 8192, (kpb), voff_kp); } while (0)
#define DMA_WAIT1() do { if (wid < 4) VMWN(3); else VMWN(2); } while (0)
#define QLOAD(ref) do { gptr qb_ = uni((const GAS void*)((ref).Q + (size_t)(wid * QBLK) * QS)); _Pragma("unroll") for (int d0 = 0; d0 < NQR; ++d0) S.qr[d0] = *reinterpret_cast<const GAS u32x2*>(qb_ + d0 * 16 + voff_q); } while (0)
#define QPLOAD(ref) do { gptr qb_ = uni((const GAS void*)((ref).Q + (size_t)(wid * QBLK) * QS)); _Pragma("unroll") for (int d0 = NQR; d0 < 12; ++d0) q12[d0] = *reinterpret_cast<const GAS u32x2*>(qb_ + d0 * 16 + voff_q); } while (0)
struct QNorm { const float* CS; const float* gqn; const float* gqr; };
__device__ __forceinline__ void unpk8(u32x2 x, float (&v)[8]) { const f32x2 a = __builtin_amdgcn_cvt_pk_f32_fp8((int)x.x, false), b = __builtin_amdgcn_cvt_pk_f32_fp8((int)x.x, true), c = __builtin_amdgcn_cvt_pk_f32_fp8((int)x.y, false), d = __builtin_amdgcn_cvt_pk_f32_fp8((int)x.y, true);
    v[0] = a.x; v[1] = a.y; v[2] = b.x; v[3] = b.y; v[4] = c.x; v[5] = c.y; v[6] = d.x; v[7] = d.y; }
__device__ __forceinline__ void unpk8_bf16(bf16x8 x, float (&v)[8]) { const u32x4 w = __builtin_bit_cast(u32x4, x);
    v[0] = bf_lo(w.x); v[1] = bf_hi(w.x); v[2] = bf_lo(w.y); v[3] = bf_hi(w.y); v[4] = bf_lo(w.z); v[5] = bf_hi(w.z); v[6] = bf_lo(w.w); v[7] = bf_hi(w.w); }
__device__ __forceinline__ bf16x8 pk8(const float (&v)[8]) { u32x4 w; w.x = cvt_pk_bf16(v[0], v[1]); w.y = cvt_pk_bf16(v[2], v[3]); w.z = cvt_pk_bf16(v[4], v[5]); w.w = cvt_pk_bf16(v[6], v[7]); return __builtin_bit_cast(bf16x8, w); }
struct QCoef { f32x4 c[4], s[4], ga[4], gb[4]; };
__device__ __forceinline__ void qcoef_load(QCoef& C, const QNorm& N, int tok, int hi) {
#pragma unroll
    for (int f = 0; f < 2; ++f) { const int i0 = f * 16 + hi * 8; const float* cp = N.CS + (size_t)tok * 64 + i0; const float* g = N.gqr + i0;
#pragma unroll
        for (int j = 0; j < 2; ++j) { C.c[2 * f + j] = *(const f32x4*)(cp + 4 * j); C.s[2 * f + j] = *(const f32x4*)(cp + 32 + 4 * j); C.ga[2 * f + j] = *(const f32x4*)(g + 4 * j); C.gb[2 * f + j] = *(const f32x4*)(g + 32 + 4 * j); } }
}
__device__ __forceinline__ void qnorm_rope(const u32x2 (&q)[12], const QCoef& C, i32x8 (&qf)[3]) {
    float sn = 0.f, sp = 0.f, v[8];
#pragma unroll
    for (int f = 0; f < 8; ++f) { unpk8(q[f], v);
#pragma unroll
        for (int e = 0; e < 8; ++e) sn += v[e] * v[e]; }
#pragma unroll
    for (int f = 8; f < 12; ++f) { unpk8(q[f], v);
#pragma unroll
        for (int e = 0; e < 8; ++e) sp += v[e] * v[e]; }
    { auto rr = __builtin_amdgcn_permlane32_swap(__float_as_uint(sn), __float_as_uint(sn), false, false); sn = __uint_as_float(rr[0]) + __uint_as_float(rr[1]); }
    { auto rr = __builtin_amdgcn_permlane32_swap(__float_as_uint(sp), __float_as_uint(sp), false, false); sp = __uint_as_float(rr[0]) + __uint_as_float(rr[1]); }
    const float rn = rsqrtf(sn * (1.f / 128.f) + RMS_EPS), rp = rsqrtf(sp * (1.f / 64.f) + RMS_EPS);
#pragma unroll
    for (int f = 0; f < 8; ++f) { unpk8(q[f], v);
#pragma unroll
        for (int e = 0; e < 8; ++e) v[e] *= rn * QSC;
        qf[f >> 2][2 * (f & 3)] = (int)cvt_pk4_fp8(v[0], v[1], v[2], v[3]); qf[f >> 2][2 * (f & 3) + 1] = (int)cvt_pk4_fp8(v[4], v[5], v[6], v[7]); }
#pragma unroll
    for (int f = 0; f < 2; ++f) {
        float t1[8], t2[8], o1[8], o2[8]; unpk8(q[8 + f], t1); unpk8(q[10 + f], t2);
#pragma unroll
        for (int e = 0; e < 8; ++e) { const int j = 2 * f + (e >> 2), k = e & 3; const float a = t1[e] * (rp * QSC) * C.ga[j][k], b = t2[e] * (rp * QSC) * C.gb[j][k]; o1[e] = a * C.c[j][k] - b * C.s[j][k]; o2[e] = b * C.c[j][k] + a * C.s[j][k]; }
        qf[2][2 * f] = (int)cvt_pk4_fp8(o1[0], o1[1], o1[2], o1[3]); qf[2][2 * f + 1] = (int)cvt_pk4_fp8(o1[4], o1[5], o1[6], o1[7]);
        qf[2][4 + 2 * f] = (int)cvt_pk4_fp8(o2[0], o2[1], o2[2], o2[3]); qf[2][5 + 2 * f] = (int)cvt_pk4_fp8(o2[4], o2[5], o2[6], o2[7]); }
}
__device__ __forceinline__ void prime(const BlockRef& cur, char* lds, Seam& S, const int wid) {
    const int lane = lane_id(), tid = wid * 64 + lane, r32 = lane & 31, hi = lane >> 5;
    DMA_SETUP();
    const unsigned voff_q = (unsigned)(r32 * QS + hi * 8);
    QLOAD(cur);
    gptr V8h = uni((const GAS void*)cur.V8); gptr K8h = uni((const GAS void*)cur.K8); gptr KPh = uni((const GAS void*)cur.KP);
    DMA_TILE(0, V8h, K8h, KPh); DMA_TILE(1, V8h + 8192, K8h + KVBLK * K8S, KPh + KVBLK * KP8S);
    S.g = 0;
}
template <int AV>
__device__ __forceinline__ void block(const BlockRef& cur, const BlockRef& nxt, char* lds, Seam& S, const int wid, const QNorm& QN) {
    const int lane = lane_id(), tid = wid * 64 + lane, r32 = lane & 31, hi = lane >> 5;
    const int NT = (cur.P0 + QB - 1) / KVBLK + 1;
    const int qlo = cur.P0 + wid * QBLK, qm = qlo + r32 - 4 * hi;
    float* ws = (float*)(lds + OFF_WS) + wid * 64; float* al_l = ws + 32;
    float m_reg = 0.f; f32x16 o[4] = {}, ol = {}, minit;
#pragma unroll
    for (int r = 0; r < 16; ++r) minit[r] = PLOG2;
    i32x8 ones;
#pragma unroll
    for (int i = 0; i < 8; ++i) ones[i] = 0x38383838;
    asm volatile("" : "+v"(ones));
    DMA_SETUP();
    const unsigned voff_q = (unsigned)(r32 * QS + hi * 8);
    const int ka = K8SW(r32, 2 * hi);
    const int g = __builtin_amdgcn_readfirstlane(S.g);
    gptr V8h = uni((const GAS void*)cur.V8); gptr K8h = uni((const GAS void*)cur.K8); gptr KPh = uni((const GAS void*)cur.KP);
    gptr nV8h = uni((const GAS void*)nxt.V8); gptr nK8h = uni((const GAS void*)nxt.K8); gptr nKPh = uni((const GAS void*)nxt.KP);
#define RESC(a) do { { if (hi == 0) al_l[r32] = (a); asm volatile("s_waitcnt lgkmcnt(0)" ::: "memory");                                  \
                     for (int d_ = 0; d_ < 4; ++d_) for (int r = 0; r < 16; ++r) o[d_][r] *= al_l[crow(r, hi)];                           \
                     for (int r = 0; r < 16; ++r) ol[r] *= al_l[crow(r, hi)]; } } while (0)
#define KBASE(t) ((t) * KVBLK)
#define INC6(x, k) (((x) + (k)) >= NSTG ? ((x) + (k) - NSTG) : ((x) + (k)))
#define STGP(st) (lds + (st) * STG)
#define ISSUE(tn, stn) do { const int tn_ = (tn); const bool in_ = tn_ < NT; const int tt_ = in_ ? tn_ : tn_ - NT;                                               \
        DMA_TILE((stn), uni((in_ ? V8h : nV8h) + (size_t)tt_ * 8192), uni((in_ ? K8h : nK8h) + (size_t)tt_ * (KVBLK * K8S)), uni((in_ ? KPh : nKPh) + (size_t)tt_ * (KVBLK * KP8S))); } while (0)
#define MASKT(P0_, P1_, t) do { const int kb_ = KBASE(t); if (kb_ + KVBLK - 1 > qlo) mask_tile(P0_, P1_, qm - kb_, (unsigned)WBIG); } while (0)
    f32x16 pA0, pA1, pB0, pB1; float mnA, mnB, alA, alB; i32x8 pa, vf[4];
    u32x2 q12[12]; QPLOAD(cur); QCoef qc_; qcoef_load(qc_, QN, cur.tok0 + wid * QBLK + r32, hi); SBAR();
    VMW(); __syncthreads();
    if (!(AV & 8)) { ISSUE(2, INC6(g, 2)); ISSUE(3, INC6(g, 3)); }
    { _Pragma("unroll") for (int d0 = 0; d0 < NQR; ++d0) q12[d0] = S.qr[d0]; }
    i32x8 qf[3];
    qnorm_rope(q12, qc_, qf);
    SBAR(); qkt(pA0, pA1, STGP(g), ka, qf, minit);
    MASKT(pA0, pA1, 0); (void)partialSM<true>(pA0, pA1, m_reg, minit, alA);
#define STEP(PX0, PX1, mnX, alX, PY0, PY1, alY, t, stx, stv) do {                                                             \
        SBAR();                                                                                                               \
        if (!(AV & 2)) qkt(PX0, PX1, STGP(stx), ka, qf, minit); else { _Pragma("unroll") for (int r_ = 0; r_ < 16; ++r_) { PX0[r_] = __int_as_float(qf[0][r_ & 7]) + PX0[r_]; PX1[r_] = __int_as_float(qf[1][r_ & 7]) + PX1[r_]; } } \
        if (!(AV & 1)) finishSM(PY0, PY1, pa); else { _Pragma("unroll") for (int v_ = 0; v_ < 8; ++v_) pa[v_] = __float_as_int(PY0[v_]) ^ __float_as_int(PY1[v_ + 8]); }  SBAR();   \
        if (!(AV & 2)) { v_read(vf, STGP(stv), ka); pv_mma(o, ol, vf, ones, pa); } else { _Pragma("unroll") for (int r_ = 0; r_ < 16; ++r_) { o[0][r_] += __int_as_float(pa[r_ & 7]); ol[r_] += 1.f; } }                \
        if (!(AV & 1)) { MASKT(PX0, PX1, (t)); if (partialSM<false>(PX0, PX1, m_reg, minit, alX)) RESC(alX); } } while (0)
    int sc = INC6(g, 1);
    if (wid < 4) __builtin_amdgcn_s_setprio(1);
    STEP(pB0, pB1, mnB, alB, pA0, pA1, alA, 1, sc, g);
    for (int t = 2; t < NT; t += 2) {
        const int sp = sc, s0 = INC6(sc, 1), s1 = INC6(sc, 2), s2 = INC6(sc, 3), s3 = INC6(sc, 4);
        VMW(); if (!(AV & 4)) __syncthreads(); if (!(AV & 8)) { ISSUE(t + 2, s2); ISSUE(t + 3, s3); }
        STEP(pA0, pA1, mnA, alA, pB0, pB1, alB, t, s0, sp);
        STEP(pB0, pB1, mnB, alB, pA0, pA1, alA, t + 1, s1, s0);
        sc = s1;
    }
    SBAR(); QLOAD(nxt); v_read(vf, STGP(sc), ka); SBAR();
    finishSM(pB0, pB1, pa); SBAR();
    pv_mma(o, ol, vf, ones, pa);
    S.g = INC6(sc, 1);
    __builtin_amdgcn_s_setprio(0);
    float rli[16];
#pragma unroll
    for (int r = 0; r < 16; ++r) rli[r] = __builtin_amdgcn_rcpf(ol[r]);
    GAS char* Ow = (GAS char*)uni((const GAS void*)(cur.O + (size_t)(wid * QBLK) * OS));
    const bool odd = (r32 & 1) != 0;
    const unsigned voff_o = (unsigned)((4 * hi + (odd ? 1 : 0)) * OS + (r32 & ~1)) * 2u;
#pragma unroll
    for (int r = 0; r < 16; r += 2) { const int orow0 = (r & 3) + 8 * (r >> 2);
#pragma unroll
        for (int d0 = 0; d0 < 4; ++d0) { const float a = o[d0][r] * rli[r], b = o[d0][r + 1] * rli[r + 1];
            const float send = odd ? a : b;
            const float recv = __int_as_float(__builtin_amdgcn_mov_dpp(__float_as_int(send), 0xB1, 0xF, 0xF, true));
            *(GAS unsigned*)(Ow + (size_t)orow0 * OS * 2 + d0 * 64 + voff_o) = cvt_pk_bf16(odd ? recv : a, odd ? b : recv); } }
    __syncthreads();
#undef RESC
#undef KBASE
#undef STGP
#undef INC6
#undef ISSUE
#undef MASKT
#undef STEP
}
#undef QLOAD
#undef QPLOAD
#undef QPWRITE
constexpr int NQB = SEQ / QB, NX = NQB / 2, NITEMS = 2 * NH * NX;
struct Item { int bh, qb0, qb1; };
__device__ __forceinline__ Item decode(int L) {
    const int xcd = L & 7, k = L >> 3; Item it; it.bh = (k / NX) * 8 + xcd; const int x = k % NX; it.qb0 = x; it.qb1 = NQB - 1 - x; return it;
}
__device__ __forceinline__ BlockRef mkref(const Item& it, int pass, const unsigned char* Q, const unsigned char* V8T, const unsigned char* K8, const unsigned char* KPE, bf16_t* O) {
    const int qb = pass ? it.qb1 : it.qb0, b = it.bh / NH, h = it.bh % NH;
    BlockRef r; const size_t t0 = (size_t)b * SEQ;
    r.Q = Q + (t0 + (size_t)qb * QB) * QS + h * 192; r.O = O + (t0 + (size_t)qb * QB) * OS + h * 128;
    r.V8 = V8T + (size_t)it.bh * (SEQ / 64) * 8192; r.K8 = K8 + t0 * K8S + h * 128; r.KP = KPE + t0 * KP8S; r.P0 = qb * QB; r.tok0 = (int)t0 + qb * QB;
    return r;
}
template <int PSEL, int AV = 0>
__device__ __forceinline__ void attn_phase(char* lds, const unsigned char* Q, const unsigned char* KV, const unsigned char* K8, const unsigned char* KPE, bf16_t* O, int G, int c, const int wid, const QNorm& QN) {
    int L = c; if (L >= NITEMS) return;
    Item it = decode(L); int pass = PSEL < 0 ? 0 : PSEL;
    BlockRef cur = mkref(it, pass, Q, KV, K8, KPE, O);
    Seam S;
    prime(cur, lds, S, wid);
    for (;;) {
        const bool more_pass = PSEL < 0 && pass == 0, more_item = L + G < NITEMS, last = !more_pass && !more_item;
        Item itn = it; int passn = pass + 1, Ln = L;
        if (!more_pass) { passn = PSEL < 0 ? 0 : PSEL; Ln = more_item ? L + G : L; itn = decode(Ln); }
        const BlockRef nxt = last ? cur : mkref(itn, passn, Q, KV, K8, KPE, O);
        block<AV>(cur, nxt, lds, S, wid, QN);
        if (last) break;
        cur = nxt; it = itn; pass = passn; L = Ln;
    }
    VMW(); __syncthreads();
}
#undef VMW
#undef VMWN
#undef ATT_DMA
#undef DMA_SETUP
#undef DMA_TILE
#undef DMA_WAIT1
}

struct Params { const float* in[22]; float* out; unsigned char* ws; int ph_lo, ph_hi; };
enum { I_X = 0, I_POS, I_GMIX, I_WIN, I_GQL, I_WUQ, I_GKVL, I_WUKV, I_GQN, I_GQR, I_GKN, I_GKR, I_WPOOL, I_SPOOL, I_WOUT, I_GFFN, I_WR, I_BR, I_WGU, I_BGU, I_WD, I_BD };

__device__ __forceinline__ void transpose_item(const float* W, int N, int k0, int n0, bf16_t* WT, int ldk, int dst_row0, LAS float* scr, int lane, const float* kgain) {
    float v[32];
#pragma unroll
    for (int i = 0; i < 32; ++i) v[i] = W[(size_t)(k0 + 2 * i + (lane >> 5)) * N + n0 + (lane & 31)];
    if (kgain) {
#pragma unroll
        for (int i = 0; i < 32; ++i) v[i] *= kgain[k0 + 2 * i + (lane >> 5)]; }
#pragma unroll
    for (int i = 0; i < 32; ++i) { const int kk = 2 * i + (lane >> 5); scr[kk * 32 + ((lane & 31) ^ ((kk >> 3) << 2))] = v[i]; }
    LDS_WAIT(); asm volatile("" ::: "memory");
    const int c = lane & 7;
#pragma unroll
    for (int j = 0; j < 4; ++j) { const int n = (lane >> 3) + 8 * j; const LAS float* s = scr + (8 * c) * 32 + (n ^ (c << 2));
        u32x4 o; o.x = cvt_pk_bf16(s[0 * 32], s[1 * 32]); o.y = cvt_pk_bf16(s[2 * 32], s[3 * 32]); o.z = cvt_pk_bf16(s[4 * 32], s[5 * 32]); o.w = cvt_pk_bf16(s[6 * 32], s[7 * 32]);
        *(u32x4*)(WT + (size_t)(dst_row0 + n) * ldk + k0 + 8 * c) = o; }
    LDS_WAIT(); asm volatile("" ::: "memory");
}

__device__ __forceinline__ void transpose_item_fp8(const float* W, int N, int k0, int n0, unsigned char* WT, int ldk, int dst_row0, LAS float* scr, int lane, const float* kgain) {
    float v[64];
#pragma unroll
    for (int i = 0; i < 64; ++i) v[i] = W[(size_t)(k0 + 2 * i + (lane >> 5)) * N + n0 + (lane & 31)];
#pragma unroll
    for (int i = 0; i < 64; ++i) { const int kk = 2 * i + (lane >> 5); scr[kk * 32 + ((lane & 31) ^ ((kk >> 4) << 2))] = v[i] * W8_SCALE; }
    LDS_WAIT(); asm volatile("" ::: "memory");
    const int c = lane & 7;
    f32x4 g[4];
#pragma unroll
    for (int q = 0; q < 4; ++q) g[q] = kgain ? *(const f32x4*)(kgain + k0 + 16 * c + 4 * q) : (f32x4){1.f, 1.f, 1.f, 1.f};
#pragma unroll
    for (int j = 0; j < 4; ++j) { const int n = (lane >> 3) + 8 * j; const LAS float* s = scr + (16 * c) * 32 + (n ^ (c << 2));
        u32x4 o; o.x = cvt_pk4_fp8(s[0 * 32] * g[0][0], s[1 * 32] * g[0][1], s[2 * 32] * g[0][2], s[3 * 32] * g[0][3]); o.y = cvt_pk4_fp8(s[4 * 32] * g[1][0], s[5 * 32] * g[1][1], s[6 * 32] * g[1][2], s[7 * 32] * g[1][3]);
        o.z = cvt_pk4_fp8(s[8 * 32] * g[2][0], s[9 * 32] * g[2][1], s[10 * 32] * g[2][2], s[11 * 32] * g[2][3]); o.w = cvt_pk4_fp8(s[12 * 32] * g[3][0], s[13 * 32] * g[3][1], s[14 * 32] * g[3][2], s[15 * 32] * g[3][3]);
        *(u32x4*)(WT + (size_t)(dst_row0 + n) * ldk + k0 + 16 * c) = o; }
    LDS_WAIT(); asm volatile("" ::: "memory");
}

typedef const GAS char* cgptr;
__device__ __forceinline__ cgptr cuni(const void* p) { const unsigned long long v = (unsigned long long)p; const unsigned lo = __builtin_amdgcn_readfirstlane((unsigned)v), hi = __builtin_amdgcn_readfirstlane((unsigned)(v >> 32)); return (cgptr)(((unsigned long long)hi << 32) | lo); }
struct ConvItem { cgptr src; cgptr dstp; unsigned N4; };
__device__ __forceinline__ ConvItem conv_decode(int it, const float* wgu, const float* wd, unsigned char* WguT, unsigned char* WdT) {
    constexpr int I_GU = NE * 16 * 128;
    ConvItem c; int r = it, nbn, N; const float* src; unsigned char* dstp; bool gu;
    if (r < I_GU) { const int e = r / (16 * 128); r -= e * (16 * 128); N = 4096; nbn = 128; src = wgu + (size_t)e * DM * 4096; dstp = WguT + (size_t)e * 4096 * DM; gu = true; }
    else { r -= I_GU; const int e = r / (16 * 64); r -= e * (16 * 64); N = DM; nbn = 64; src = wd + (size_t)e * DFF * DM; dstp = WdT + (size_t)e * DM * DFF; gu = false; }
    const int kb = r / nbn, nb = r - kb * nbn, n0 = nb * 32, k0 = kb * 128; int dst = n0;
    if (gu) { const int j = n0 & 2047; dst = (j >> 7) * 256 + (j & 127) + ((n0 >= 2048) ? 128 : 0); }
    c.src = cuni(src + (size_t)k0 * N + n0); c.dstp = cuni(dstp + (size_t)dst * DM + k0); c.N4 = (unsigned)N * 4u;
    return c;
}
#define CONV_LOAD(v, c) do { const unsigned lo_ = (unsigned)(lane >> 3) * (c).N4 + 16u * (unsigned)(lane & 7); _Pragma("unroll") for (int i = 0; i < 16; ++i) v[i] = __builtin_nontemporal_load((const GAS f32x4*)(cuni((const void*)((c).src + (size_t)(8 * i) * (c).N4)) + lo_)); } while (0)
#define CONV_STORE(v, c) do { _Pragma("unroll") for (int i = 0; i < 16; ++i) { const int kk_ = 8 * i + (lane >> 3); *(LAS f32x4*)(scr + kk_ * 32 + ((4 * (lane & 7)) ^ ((kk_ >> 4) << 2))) = v[i] * W8_SCALE; }     \
        LDS_WAIT(); asm volatile("" ::: "memory"); const int ch_ = lane & 7; const unsigned so_ = (unsigned)(lane >> 3) * (unsigned)DM + 16u * (unsigned)ch_;                          \
        _Pragma("unroll") for (int j = 0; j < 4; ++j) { const int n = (lane >> 3) + 8 * j; const LAS float* s_ = scr + (16 * ch_) * 32 + (n ^ (ch_ << 2));                       \
            u32x4 o; o.x = cvt_pk4_fp8(s_[0 * 32], s_[1 * 32], s_[2 * 32], s_[3 * 32]); o.y = cvt_pk4_fp8(s_[4 * 32], s_[5 * 32], s_[6 * 32], s_[7 * 32]);                     \
            o.z = cvt_pk4_fp8(s_[8 * 32], s_[9 * 32], s_[10 * 32], s_[11 * 32]); o.w = cvt_pk4_fp8(s_[12 * 32], s_[13 * 32], s_[14 * 32], s_[15 * 32]);                       \
            __builtin_nontemporal_store(o, (GAS u32x4*)((GAS char*)cuni((const void*)((c).dstp + (size_t)(8 * j) * DM)) + so_)); }                                                                    \
        LDS_WAIT(); asm volatile("" ::: "memory"); } while (0)
__device__ __forceinline__ void convert_expert_weights(const float* wgu, const float* wd, unsigned char* WguT, unsigned char* WdT, LAS float* scr, int gw, int NGW, int NIT, int lane) {
    int it = gw; if (it >= NIT) return;
    f32x4 va[16], vb[16];
    ConvItem ca = conv_decode(it, wgu, wd, WguT, WdT), cb = ca;
    CONV_LOAD(va, ca);
    for (;;) {
        const bool hb = it + NGW < NIT; cb = conv_decode(hb ? it + NGW : it, wgu, wd, WguT, WdT); CONV_LOAD(vb, cb);
        CONV_STORE(va, ca);
        if (!hb) break;
        it += NGW;
        const bool ha = it + NGW < NIT; ca = conv_decode(ha ? it + NGW : it, wgu, wd, WguT, WdT); CONV_LOAD(va, ca);
        CONV_STORE(vb, cb);
        if (!ha) break;
        it += NGW;
    }
}
#undef CONV_LOAD
#undef CONV_STORE

__device__ __forceinline__ void moe_tables(const unsigned* cnt, LAS int* ts, const int tid) {
    if (tid < NE) ts[64 + tid] = (int)__hip_atomic_load(cnt + tid, RLX_AGENT);
    __syncthreads();
    if (tid == 0) { int acc = 0;
        for (int e = 0; e < NE; ++e) { ts[e] = acc; acc += (ts[64 + e] + 255) >> 8; }
        ts[NE] = acc < MT_MAX ? acc : MT_MAX; }
    __syncthreads();
}

__global__ void __launch_bounds__(512, 2) fwd_kernel(Params p) {
    extern __shared__ __attribute__((aligned(16))) unsigned char lds_raw[];
    LAS unsigned char* lds = (LAS unsigned char*)lds_raw;
    volatile LAS unsigned* MISC = (volatile LAS unsigned*)(lds + MISC_OFF);
    const int wave = __builtin_amdgcn_readfirstlane((int)threadIdx.x >> 6);
#define LANE_TID() const int lane = lane_id(), tid = wave * 64 + lane
    const int G = gridDim.x, bx = blockIdx.x;
    const int vcu = (G % 8 == 0) ? (bx % 8) * (G / 8) + bx / 8 : bx;
    unsigned char* ws = p.ws;
    unsigned* ctl = (unsigned*)(ws + WS_CTL);
    { LANE_TID(); for (int u = tid; u < 1024; u += 512) MISC[u] = 0u; }
    __syncthreads();
    XcdBarrier bar; bar.bar = ctl + CW_BAR; bar.x = 0; bar.st = nullptr;
    if (N_LAUNCHES == 1) bar = xcd_barrier_post(ctl + CW_BAR, MISC + 8, wave == 0 && lane_id() == 0);
#define GRID_BAR() do { if (N_LAUNCHES == 1) xcd_barrier(bar, wave == 0 && lane_id() == 0); } while (0)
    const int lo = (N_LAUNCHES == 1 && PROBE_PHASE < 0) ? 0 : p.ph_lo, hi = (N_LAUNCHES == 1 && PROBE_PHASE < 0) ? NPH : p.ph_hi;
#define IN(k) (lo <= (k) && (k) < hi)
#define BOTH(k) (IN(k) && IN((k) + 1))
    const int gw = vcu * 8 + wave, NGW = G * 8, NGT = G * 512;
#define GT() (vcu * 512 + tid)

    bf16_t* WinT = (bf16_t*)(ws + WS_WIN + 16 * MiB); bf16_t* WuqT = (bf16_t*)(ws + WS_WUQ); bf16_t* WukvT = (bf16_t*)(ws + WS_WUKV); bf16_t* WpoolT = (bf16_t*)(ws + WS_WPOOL);
    bf16_t* WoutT = (bf16_t*)(ws + WS_WOUT); float* WrT = (float*)(ws + WS_WRT); unsigned char* WguT = ws + WS_WGU; unsigned char* WdT = ws + WS_WD;
    bf16_t* Hb = (bf16_t*)(ws + WS_H); bf16_t* Zb = (bf16_t*)(ws + WS_Z); bf16_t* NQ = (bf16_t*)(ws + WS_NQ); bf16_t* NKV = (bf16_t*)(ws + WS_NKV);
    unsigned char* KPE8 = ws + WS_KPE; unsigned char* K8b = ws + WS_NQ; unsigned char* V8T = ws + WS_KV; unsigned char* Z8 = ws + WS_KV + 64 * MiB; unsigned char* G8 = ws + WS_YP;
    bf16_t* POOLED = (bf16_t*)(ws + WS_POOLED); unsigned char* Qb = ws + WS_Q; bf16_t* KVb = (bf16_t*)(ws + WS_KV);
    bf16_t* YP = (bf16_t*)(ws + WS_YP); bf16_t* YA = (bf16_t*)(ws + WS_YA); bf16_t* MERGED = (bf16_t*)(ws + WS_MERGED); unsigned char* H2 = ws + WS_H2;
    unsigned char* H8 = ws + WS_H8; unsigned char* Win8 = ws + WS_WIN; unsigned char* XS = ws + WS_XSP; unsigned char* ACT = ws + WS_ACT; unsigned char* Yb = ws + WS_Y;
    int* tok_e = (int*)(ws + WS_ROUTE); float* tok_w = (float*)(ws + WS_ROUTE + 256 * 1024); int* tok_rank = (int*)(ws + WS_ROUTE + 512 * 1024); int* tok_pos = (int*)(ws + WS_ROUTE + 768 * 1024);
    float* row_w = (float*)(ws + WS_ROWT); float* CS = (float*)(ws + WS_CS);
    float* RSQ = (float*)(ws + WS_ROUTE + 1536 * 1024); float* RSKV = (float*)(ws + WS_ROUTE + 1600 * 1024);
    float* RS2 = (float*)(ws + WS_ROUTE + 1664 * 1024); float* row_rs = (float*)(ws + WS_ROWT + 2 * MiB);
    bf16_t* X1 = (bf16_t*)(ws + WS_X1);

    if (IN(0)) { LANE_TID();
        LAS float* scr = (LAS float*)(lds + wave * 16896);
        constexpr int I_IN = 32 * 34, I_IN8 = 16 * 160, I_UQ = 4 * 96, I_UKV = 4 * 128, I_PL = 4 * 4 * 16, I_OUT = 32 * 64;
        constexpr int NITEMS = I_IN + I_IN8 + I_UQ + I_UKV + I_PL + I_OUT;
        for (int it = gw; it < NITEMS; it += NGW) {
            int r = it, idx, N, nbn, ldk; size_t soff = 0, doff; bool f8 = false;
            if (r < I_IN) { idx = I_WIN; N = 6208; nbn = 34; ldk = DM; soff = 1024; doff = WS_WKR; }
            else if ((r -= I_IN) < I_IN8) { idx = I_WIN; N = 6208; nbn = 160; ldk = DM; doff = WS_WIN; f8 = true; }
            else if ((r -= I_IN8) < I_UQ) { idx = I_WUQ; N = 3072; nbn = 96; ldk = 512; doff = WS_WUQ; f8 = true; }
            else if ((r -= I_UQ) < I_UKV) { idx = I_WUKV; N = 4096; nbn = 128; ldk = 512; doff = WS_WUKV; f8 = true; }
            else if ((r -= I_UKV) < I_PL) { const int g = r / 64; r -= g * 64; idx = I_WPOOL; N = 512; nbn = 16; ldk = 256; soff = (size_t)g * 256 * 512; doff = WS_WPOOL + (size_t)g * 512 * 256 * 2; }
            else { r -= I_PL; idx = I_WOUT; N = DM; nbn = 64; ldk = DM; doff = WS_WOUT; }
            const int kb = r / nbn, nb = r - kb * nbn, n0 = nb * 32;
            int dst = n0;
            if (idx == I_WIN && f8 && n0 >= 1024) soff = 1088;
            if (idx == I_WIN && !f8 && n0 >= 64) { dst = n0 - 64; doff = WS_WIN + 16 * MiB; }
            const float* src = p.in[idx] + soff;
            if (f8) transpose_item_fp8(src, N, kb * 128, n0, ws + doff, ldk, dst, scr, lane, idx == I_WUQ ? p.in[I_GQL] : (idx == I_WUKV ? p.in[I_GKVL] : nullptr));
            else transpose_item(src, N, kb * 64, n0, (bf16_t*)(ws + doff), ldk, dst, scr, lane, nullptr);
        }
        for (int i = GT(); i < NE * DM; i += NGT) { const int e = i / DM, k = i % DM; WrT[i] = p.in[I_GFFN][k] * p.in[I_WR][(size_t)k * NE + e]; }
        for (int m = gw; m < T; m += NGW) {
            const f32x4* xr = (const f32x4*)(p.in[I_X] + (size_t)m * DM) + lane; const f32x4* gr = (const f32x4*)p.in[I_GMIX] + lane;
            f32x4 v[8]; float s = 0.f;
#pragma unroll
            for (int j = 0; j < 8; ++j) { v[j] = xr[64 * j]; s += (v[j].x * v[j].x + v[j].y * v[j].y) + (v[j].z * v[j].z + v[j].w * v[j].w); }
            const float rstd = rsqrtf(wave_sum(s) * (1.f / DM) + RMS_EPS);
            u32x2* o8 = (u32x2*)(Hb + (size_t)m * DM) + lane; unsigned* o4 = (unsigned*)(H8 + (size_t)m * DM) + lane;
#pragma unroll
            for (int j = 0; j < 8; ++j) { const f32x4 g = gr[64 * j]; const f32x4 hv = v[j] * rstd * g; u32x2 w; w.x = cvt_pk_bf16(hv.x, hv.y); w.y = cvt_pk_bf16(hv.z, hv.w); o8[64 * j] = w; o4[64 * j] = cvt_pk4_fp8(hv.x, hv.y, hv.z, hv.w); }
        }
        if (BOTH(0)) GRID_BAR();
    }

    if (IN(1)) {
        { pg8::DenseOrder S; S.init((const bf16_t*)H8, DM / 2, (const bf16_t*)Win8 + (size_t)1024 * (DM / 2), DM / 2, T, 4096, G, bx); pg8::EpiGate E{G8, 1.0f / W8_SCALE}; pg8::gemm_phase<true>(lds, DM / 2, DM / 2, DM / 2, S, E, wave); }
        { pg8::DenseOrder S; S.init((const bf16_t*)H8, DM / 2, (const bf16_t*)Win8, DM / 2, T, 1024, G, bx); pg8::EpiLat E{Z8, 1.0f / W8_SCALE}; pg8::gemm_phase<true>(lds, DM / 2, DM / 2, DM / 2, S, E, wave); }
        { pg8::DenseOrder S; S.init(Hb, DM, WinT, DM, T, 1024, G, bx); pg8::EpiBf16 E{Zb + ZO_POOL, ZLD, 1.0f}; pg8::gemm_phase(lds, DM, DM, DM, S, E, wave); }
        if (BOTH(1)) GRID_BAR();
    }

    if (IN(2)) { LANE_TID();
        bf16_t* WkrT = (bf16_t*)(ws + WS_WKR);
        LAS float* zk = (LAS float*)lds;
        for (int blk = vcu; blk < T / 64; blk += G) {
            {
                const int tt = wave & 1, kq = wave >> 1, j = lane & 31, hh = lane >> 5;
                const bf16_t* hr = Hb + (size_t)(blk * 64 + tt * 32 + j) * DM + kq * 512 + hh * 8;
                const bf16_t* w0 = WkrT + (size_t)j * DM + kq * 512 + hh * 8; const bf16_t* w1 = w0 + (size_t)32 * DM;
                f32x16 a0 = {}, a1 = {};
                bf16x8 hb[32], b0[2][4], b1[2][4];
#pragma unroll
                for (int i = 0; i < 32; ++i) hb[i] = *(const bf16x8*)(hr + i * 16);
#pragma unroll
                for (int i = 0; i < 4; ++i) { b0[0][i] = *(const bf16x8*)(w0 + i * 16); b1[0][i] = *(const bf16x8*)(w1 + i * 16); }
#pragma unroll
                for (int ch = 0; ch < 8; ++ch) {
                    if (ch + 1 < 8) {
#pragma unroll
                        for (int i = 0; i < 4; ++i) { b0[(ch + 1) & 1][i] = *(const bf16x8*)(w0 + (ch + 1) * 64 + i * 16); b1[(ch + 1) & 1][i] = *(const bf16x8*)(w1 + (ch + 1) * 64 + i * 16); } }
#pragma unroll
                    for (int i = 0; i < 4; ++i) { a0 = __builtin_amdgcn_mfma_f32_32x32x16_bf16(b0[ch & 1][i], hb[ch * 4 + i], a0, 0, 0, 0); a1 = __builtin_amdgcn_mfma_f32_32x32x16_bf16(b1[ch & 1][i], hb[ch * 4 + i], a1, 0, 0, 0); }
                }
                LAS float* pp = zk + (kq * 64 + tt * 32 + j) * 65;
#pragma unroll
                for (int r = 0; r < 16; ++r) { const int c = (r & 3) + 8 * (r >> 2) + 4 * hh; pp[c] = a0[r]; pp[32 + c] = a1[r]; }
            }
            __syncthreads();
            const float inv_freq = powf(10000.0f, -(float)(2 * (lane & 31)) / 64.0f);
#pragma unroll 1
            for (int tl = wave * 8; tl < wave * 8 + 8; ++tl) {
                const int m = blk * 64 + tl;
                const bf16_t* zr = Zb + (size_t)m * ZLD;
                {
                    const u32x2 zq = *(const u32x2*)(Z8 + (size_t)m * 1024 + lane * 8), zkv = *(const u32x2*)(Z8 + (size_t)m * 1024 + 512 + lane * 8);
                    const f32x2 q0 = __builtin_amdgcn_cvt_pk_f32_fp8((int)zq.x, false), q1 = __builtin_amdgcn_cvt_pk_f32_fp8((int)zq.x, true), q2 = __builtin_amdgcn_cvt_pk_f32_fp8((int)zq.y, false), q3 = __builtin_amdgcn_cvt_pk_f32_fp8((int)zq.y, true);
                    const f32x2 k0 = __builtin_amdgcn_cvt_pk_f32_fp8((int)zkv.x, false), k1 = __builtin_amdgcn_cvt_pk_f32_fp8((int)zkv.x, true), k2 = __builtin_amdgcn_cvt_pk_f32_fp8((int)zkv.y, false), k3 = __builtin_amdgcn_cvt_pk_f32_fp8((int)zkv.y, true);
                    const float vq[8] = {q0.x, q0.y, q1.x, q1.y, q2.x, q2.y, q3.x, q3.y};
                    const float vk[8] = {k0.x, k0.y, k1.x, k1.y, k2.x, k2.y, k3.x, k3.y};
                    float sq = 0.f, sk = 0.f;
#pragma unroll
                    for (int q = 0; q < 8; ++q) { sq += vq[q] * vq[q]; sk += vk[q] * vk[q]; }
                    sq = wave_sum(sq); sk = wave_sum(sk);
                    if (lane == 0) { RSQ[m] = rsqrtf(sq * (1.f / 512.f) + RMS_EPS); RSKV[m] = rsqrtf(sk * (1.f / 512.f) + RMS_EPS); }
                }
                {
                    const float pos = (float)((const int*)p.in[I_POS])[m];
                    const int i = lane & 31;
                    const float ang = pos * inv_freq; float sn, cs; sincosf(ang, &sn, &cs);
                    if (lane < 32) { CS[(size_t)m * 64 + i] = cs; CS[(size_t)m * 64 + 32 + i] = sn; }
                    float z1 = 0.f, z2 = 0.f;
#pragma unroll
                    for (int q = 0; q < 4; ++q) { z1 += zk[(q * 64 + tl) * 65 + i]; z2 += zk[(q * 64 + tl) * 65 + 32 + i]; }
                    float sm = (lane < 32) ? (z1 * z1 + z2 * z2) : 0.f;
                    const float rstd = rsqrtf(wave_sum(sm) * (1.f / 64.f) + RMS_EPS);
                    const float t1 = z1 * (rstd * att::KSC) * p.in[I_GKR][i], t2 = z2 * (rstd * att::KSC) * p.in[I_GKR][32 + i];
                    const float o1 = t1 * cs - t2 * sn, o2 = t2 * cs + t1 * sn;
                    const unsigned pk = cvt_pk4_fp8(o1, o2, 0.f, 0.f);
                    const int pp1 = 32 * ((i >> 3) & 1) + 8 * (i >> 4) + (i & 7);
                    if (lane < 32) { KPE8[(size_t)m * 64 + pp1] = (unsigned char)(pk & 0xffu); KPE8[(size_t)m * 64 + pp1 + 16] = (unsigned char)((pk >> 8) & 0xffu); }
                }
            }
            __syncthreads();
        }
#define POOL_BODY(W) do { u32x4 z[15 + W];                                                                                   \
            _Pragma("unroll") for (int t = 0; t < 16; ++t) z[W - 1 + t] = *(const u32x4*)(zp + (size_t)t * ZLD);              \
            _Pragma("unroll") for (int j = 1; j < W; ++j) z[W - 1 - j] = (sp0 - j >= 0) ? *(const u32x4*)(zp - (size_t)j * ZLD) : (u32x4){0u, 0u, 0u, 0u};   \
            float a[8] = {0.f, 0.f, 0.f, 0.f, 0.f, 0.f, 0.f, 0.f};                                                           \
            _Pragma("unroll") for (int j = 1; j < W; ++j) { const u32x4 h = z[W - 1 - j]; a[0] += bf_lo(h.x); a[1] += bf_hi(h.x); a[2] += bf_lo(h.y); a[3] += bf_hi(h.y); a[4] += bf_lo(h.z); a[5] += bf_hi(h.z); a[6] += bf_lo(h.w); a[7] += bf_hi(h.w); }   \
            _Pragma("unroll") for (int t = 0; t < 16; ++t) { const u32x4 c = z[W - 1 + t];                                    \
                const float u0[8] = {bf_lo(c.x), bf_hi(c.x), bf_lo(c.y), bf_hi(c.y), bf_lo(c.z), bf_hi(c.z), bf_lo(c.w), bf_hi(c.w)};                             \
                _Pragma("unroll") for (int q = 0; q < 8; ++q) a[q] += u0[q];                                                  \
                const int cnt = (sp0 + t + 1) < W ? (sp0 + t + 1) : W; const float inv = 1.0f / (float)cnt;                   \
                u32x4 o; o.x = cvt_pk_bf16(a[0] * inv - u0[0], a[1] * inv - u0[1]); o.y = cvt_pk_bf16(a[2] * inv - u0[2], a[3] * inv - u0[3]);                     \
                o.z = cvt_pk_bf16(a[4] * inv - u0[4], a[5] * inv - u0[5]); o.w = cvt_pk_bf16(a[6] * inv - u0[6], a[7] * inv - u0[7]);                             \
                *(u32x4*)(op + (size_t)t * 1024) = o;                                                                         \
                const u32x4 l = z[t];                                       \
                a[0] -= bf_lo(l.x); a[1] -= bf_hi(l.x); a[2] -= bf_lo(l.y); a[3] -= bf_hi(l.y); a[4] -= bf_lo(l.z); a[5] -= bf_hi(l.z); a[6] -= bf_lo(l.w); a[7] -= bf_hi(l.w); } } while (0)
        for (int wv = gw; wv < (T / 32) * 4; wv += NGW) {
            const int g = wv & 3, m0 = ((wv >> 2) * 2 + (lane >> 5)) * 16, ch = g * 32 + (lane & 31), sp0 = m0 & (SEQ - 1);
            const bf16_t* zp = Zb + (size_t)m0 * ZLD + ZO_POOL + ch * 8; bf16_t* op = POOLED + (size_t)m0 * 1024 + ch * 8;
            if (g == 0) POOL_BODY(2); else if (g == 1) POOL_BODY(4); else if (g == 2) POOL_BODY(8); else POOL_BODY(16);
        }
#undef POOL_BODY
        if (BOTH(2)) GRID_BAR();
    }

    if (IN(3)) {
        { pg8::DenseOrder S; S.init((const bf16_t*)Z8, 512, WuqT, 256, T, 3072, G, bx); pg8::EpiRowScale E{Qb, 3072, RSQ}; pg8::gemm_phase<true>(lds, 256, 512, 256, S, E, wave); }
        { pg8::DenseOrder S; S.init((const bf16_t*)(Z8 + 512), 512, WukvT, 256, T, 4096, G, bx); pg8::EpiKV E{K8b, V8T, RSKV, p.in[I_GKN], p.in[I_GQN], (LAS float*)(lds + 131072)}; pg8::gemm_phase<true>(lds, 256, 512, 256, S, E, wave); }
        if (BOTH(3)) GRID_BAR();
    }


    if (IN(5)) {
        const att::QNorm QN{CS, p.in[I_GQN], p.in[I_GQR]};
        const int grp = (bx >> 3) % 5;
        constexpr int CNIT = NE * 16 * 128 + NE * 16 * 64;
        const bool compact = (G == 256);
        const int gcus = grp < 2 ? 56 : 48, grank = (bx & 7) * (gcus / 8) + (bx >> 3) / 5,     gstart = (grp < 2 ? grp * 56 : 112 + (grp - 2) * 48) * (CNIT / 256);
        const int cfirst = compact ? gstart + grank * 8 + wave : gw, cstride = compact ? gcus * 8 : NGW, cend = compact ? gstart + gcus * (CNIT / 256) : CNIT;
#define CONV_SLOT(g) do { if (grp == (g)) { const int lane = lane_id(); convert_expert_weights(p.in[I_WGU], p.in[I_WD], WguT, WdT, (LAS float*)(lds + wave * 16896), cfirst, cstride, cend, lane); } __syncthreads(); } while (0)
        CONV_SLOT(0);
        att::attn_phase<0>((char*)lds_raw, Qb, V8T, K8b, KPE8, YA, 2 * G, bx, wave, QN);
        CONV_SLOT(1);
        att::attn_phase<1>((char*)lds_raw, Qb, V8T, K8b, KPE8, YA, 2 * G, bx, wave, QN);
        CONV_SLOT(2);
        att::attn_phase<0>((char*)lds_raw, Qb, V8T, K8b, KPE8, YA, 2 * G, bx + G, wave, QN);
        CONV_SLOT(3);
        att::attn_phase<1>((char*)lds_raw, Qb, V8T, K8b, KPE8, YA, 2 * G, bx + G, wave, QN);
        CONV_SLOT(4);
#undef CONV_SLOT
        if (BOTH(5)) GRID_BAR();
    }

    if (IN(6)) {
        { pg8::PoolOrder S; S.init(POOLED, 1024, WpoolT, 256, T, 2048, G, bx); pg8::EpiPool E{MERGED, G8, YA, p.in[I_SPOOL]}; pg8::gemm_phase(lds, 256, 1024, 256, S, E, wave); }
        if (BOTH(6)) GRID_BAR();
    }

    if (IN(7)) {
        pg8::DenseOrder S; S.init(MERGED, DM, WoutT, DM, T, DM, G, bx);
        pg8::EpiOut E{p.in[I_X], X1, H2, p.in[I_GFFN]};
        pg8::gemm_phase(lds, DM, DM, DM, S, E, wave);
        if (BOTH(7)) GRID_BAR();
    }

    if (IN(8)) { LANE_TID();
        LAS float* part = (LAS float*)lds;
        LAS float* ssq = (LAS float*)(lds + 36864);
        LAS int* lrk = (LAS int*)(lds + 40960);
        LAS int* hist = (LAS int*)(lds + 53760);
        LAS int* base = (LAS int*)(lds + 54016);
        unsigned* cnt = ctl + CW_CNT;
        for (int blk = vcu; blk < T / 64; blk += G) {
            const int tt = wave & 1, kq = wave >> 1, j = lane & 31, hh = lane >> 5;
            if (tid < 32) hist[tid] = 0;
            {
                const bf16_t* xr = X1 + (size_t)(blk * 64 + tt * 32 + j) * DM + kq * 512 + hh * 4;
                const float* wr_ = WrT + (size_t)j * DM + kq * 512 + hh * 4;
                f32x16 acc = {}; float ss = 0.f;
                u32x2 xb[2][8]; f32x4 wb[2][8];
#pragma unroll
                for (int i = 0; i < 8; ++i) { xb[0][i] = *(const u32x2*)(xr + i * 8); wb[0][i] = *(const f32x4*)(wr_ + i * 8); }
#pragma unroll
                for (int ch = 0; ch < 8; ++ch) {
                    if (ch + 1 < 8) {
#pragma unroll
                        for (int i = 0; i < 8; ++i) { xb[(ch + 1) & 1][i] = *(const u32x2*)(xr + (ch + 1) * 64 + i * 8); wb[(ch + 1) & 1][i] = *(const f32x4*)(wr_ + (ch + 1) * 64 + i * 8); } }
#pragma unroll
                    for (int i = 0; i < 8; ++i) { const u32x2 xp = xb[ch & 1][i]; const f32x4 xv = {bf_lo(xp.x), bf_hi(xp.x), bf_lo(xp.y), bf_hi(xp.y)}, wv = wb[ch & 1][i];
                        acc = __builtin_amdgcn_mfma_f32_32x32x2f32(wv.x, xv.x, acc, 0, 0, 0); acc = __builtin_amdgcn_mfma_f32_32x32x2f32(wv.y, xv.y, acc, 0, 0, 0);
                        acc = __builtin_amdgcn_mfma_f32_32x32x2f32(wv.z, xv.z, acc, 0, 0, 0); acc = __builtin_amdgcn_mfma_f32_32x32x2f32(wv.w, xv.w, acc, 0, 0, 0);
                        ss += (xv.x * xv.x + xv.y * xv.y) + (xv.z * xv.z + xv.w * xv.w); }
                }
                LAS float* pp = part + ((kq * 2 + tt) * 32 + j) * 33;
#pragma unroll
                for (int r = 0; r < 16; ++r) pp[(r & 3) + 8 * (r >> 2) + 4 * hh] = acc[r];
                ssq[((kq * 2 + tt) * 32 + j) * 2 + hh] = ss;
            }
            __syncthreads();
            int te[4];
            if (tid < 64) {
                const int t2 = tid >> 5, jj = tid & 31, tok = blk * 64 + tid;
                float s = 0.f;
#pragma unroll
                for (int q = 0; q < 4; ++q) s += ssq[((q * 2 + t2) * 32 + jj) * 2] + ssq[((q * 2 + t2) * 32 + jj) * 2 + 1];
                const float rstd = rsqrtf(s * (1.f / DM) + RMS_EPS);
                RS2[tok] = rstd;
                float lgv[NE];
#pragma unroll
                for (int e = 0; e < NE; ++e) { float v = 0.f;
#pragma unroll
                    for (int q = 0; q < 4; ++q) v += part[((q * 2 + t2) * 32 + jj) * 33 + e];
                    lgv[e] = v * rstd + p.in[I_BR][e]; }
                unsigned mask = 0u; float tv[4];
#pragma unroll
                for (int k = 0; k < 4; ++k) { float best = -__builtin_inff(); int be = 0;
#pragma unroll
                    for (int e = 0; e < NE; ++e) { const bool take = !((mask >> e) & 1u) && lgv[e] > best; best = take ? lgv[e] : best; be = take ? e : be; }
                    mask |= 1u << be; tv[k] = best; te[k] = be; }
                float ex[4], sum = 0.f;
#pragma unroll
                for (int k = 0; k < 4; ++k) { ex[k] = __expf(tv[k] - tv[0]); sum += ex[k]; }
                const float inv = 1.0f / sum;
#pragma unroll
                for (int k = 0; k < 4; ++k) { lrk[tid * 4 + k] = atomicAdd((int*)&hist[te[k]], 1); tok_e[tok * 4 + k] = te[k]; tok_w[tok * 4 + k] = ex[k] * inv; }
            }
            __syncthreads();
            if (tid < 32) base[tid] = (int)__hip_atomic_fetch_add(cnt + tid, (unsigned)hist[tid], RLX_AGENT);
            __syncthreads();
            if (tid < 64) { const int tok = blk * 64 + tid; const float rsv = RS2[tok];
#pragma unroll
                for (int k = 0; k < 4; ++k) { const int rk = base[te[k]] + lrk[tid * 4 + k]; tok_rank[tok * 4 + k] = rk; lrk[tid * 4 + k] = te[k] * XCAP + rk;
                    row_w[(size_t)te[k] * XCAP + rk] = tok_w[tok * 4 + k]; row_rs[(size_t)te[k] * XCAP + rk] = rsv; } }
            __syncthreads();
            for (int q0 = wave; q0 < 256; q0 += 64) {
                u32x4 ra[8], rb[8]; int srow[8];
#pragma unroll
                for (int u = 0; u < 8; ++u) { const int q = q0 + 8 * u; srow[u] = lrk[q]; const u32x4* src = (const u32x4*)(H2 + (size_t)(blk * 64 + (q >> 2)) * DM) + lane; ra[u] = src[0]; rb[u] = src[64]; }
#pragma unroll
                for (int u = 0; u < 8; ++u) { u32x4* dst = (u32x4*)(XS + (size_t)srow[u] * DM) + lane; dst[0] = ra[u]; dst[64] = rb[u]; } }
            __syncthreads();
        }
        if (BOTH(8)) GRID_BAR();
    }

    LAS int* ts = (LAS int*)(lds + MISC_OFF + 256);

    if (IN(10)) { LANE_TID();
        moe_tables(ctl + CW_CNT, ts, tid);
        pg8::MoeOrder S; S.init(XS, 1, WguT, (size_t)4096 * DM, DM, ts, 16, G, bx);
        pg8::EpiSwiglu E{ACT, p.in[I_BGU], row_rs};
        pg8::gemm_phase<true>(lds, DM / 2, DM / 2, DM / 2, S, E, wave);
        if (BOTH(10)) GRID_BAR();
    }

    if (IN(11)) { LANE_TID();
        moe_tables(ctl + CW_CNT, ts, tid);
        pg8::MoeOrder S; S.init(ACT, 0, WdT, (size_t)DM * DFF, DFF, ts, 8, G, bx);
        pg8::EpiDown E{Yb, p.in[I_BD], row_w};
        pg8::gemm_phase<true>(lds, DFF / 2, DFF / 2, DFF / 2, S, E, wave);
        if (BOTH(11)) GRID_BAR();
    }

    if (IN(12)) { LANE_TID();
        moe_tables(ctl + CW_CNT, ts, tid);
        constexpr int NI = T * (DM / 16), UN = 4;
        for (int it0 = GT(); it0 < NI; it0 += UN * NGT) {
            int mm[UN], cc[UN], ee[UN][4], rk[UN][4]; u32x4 xa[UN], xb[UN], y[UN][4];
#pragma unroll
            for (int u = 0; u < UN; ++u) { const int it = it0 + u * NGT < NI ? it0 + u * NGT : it0; mm[u] = it >> 7; cc[u] = (it & 127) * 16;
                const i32x4 e4 = *(const i32x4*)(tok_e + mm[u] * 4), r4 = *(const i32x4*)(tok_rank + mm[u] * 4);
#pragma unroll
                for (int k = 0; k < 4; ++k) { ee[u][k] = e4[k]; rk[u][k] = r4[k]; }
                const bf16_t* xp = X1 + (size_t)mm[u] * DM + cc[u]; xa[u] = *(const u32x4*)xp; xb[u] = *(const u32x4*)(xp + 8); }
#pragma unroll
            for (int u = 0; u < UN; ++u)
#pragma unroll
                for (int k = 0; k < 4; ++k) { const int pos = ts[ee[u][k]] * 256 + rk[u][k]; y[u][k] = *(const u32x4*)(Yb + (size_t)pos * DM + cc[u]); }
#pragma unroll
            for (int u = 0; u < UN; ++u) {
                f32x4 a[4];
                a[0] = (f32x4){bf_lo(xa[u].x), bf_hi(xa[u].x), bf_lo(xa[u].y), bf_hi(xa[u].y)}; a[1] = (f32x4){bf_lo(xa[u].z), bf_hi(xa[u].z), bf_lo(xa[u].w), bf_hi(xa[u].w)};
                a[2] = (f32x4){bf_lo(xb[u].x), bf_hi(xb[u].x), bf_lo(xb[u].y), bf_hi(xb[u].y)}; a[3] = (f32x4){bf_lo(xb[u].z), bf_hi(xb[u].z), bf_lo(xb[u].w), bf_hi(xb[u].w)};
#pragma unroll
                for (int k = 0; k < 4; ++k)
#pragma unroll
                    for (int q = 0; q < 4; ++q) { const f32x2 lo = __builtin_amdgcn_cvt_pk_f32_fp8((int)y[u][k][q], false), hi = __builtin_amdgcn_cvt_pk_f32_fp8((int)y[u][k][q], true);
                        a[q].x += lo.x * (1.0f / Y8_SCALE); a[q].y += lo.y * (1.0f / Y8_SCALE); a[q].z += hi.x * (1.0f / Y8_SCALE); a[q].w += hi.y * (1.0f / Y8_SCALE); }
                if (it0 + u * NGT < NI) { float* op = p.out + (size_t)mm[u] * DM + cc[u];
#pragma unroll
                    for (int q = 0; q < 4; ++q) *(f32x4*)(op + 4 * q) = a[q]; }
            }
        }
    }
#undef IN
#undef BOTH
#undef GRID_BAR
}

#ifndef PROBE_AV
#define PROBE_AV -1
#endif
#if PROBE_AV >= 0
__global__ void __launch_bounds__(512, 2) probe_attn_kernel(Params p) {
    extern __shared__ __attribute__((aligned(16))) unsigned char lds_raw[];
    const int wave = __builtin_amdgcn_readfirstlane((int)threadIdx.x >> 6);
    const int G = gridDim.x, bx = blockIdx.x;
    unsigned char* ws = p.ws;
    const att::QNorm QN{(float*)(ws + WS_CS), p.in[I_GQN], p.in[I_GQR]};
    const unsigned char* Qb = ws + WS_Q; bf16_t* YA = (bf16_t*)(ws + WS_YA);
    att::attn_phase<0, PROBE_AV>((char*)lds_raw, Qb, ws + WS_KV, ws + WS_NQ, ws + WS_KPE, YA, 2 * G, bx, wave, QN);
    att::attn_phase<1, PROBE_AV>((char*)lds_raw, Qb, ws + WS_KV, ws + WS_NQ, ws + WS_KPE, YA, 2 * G, bx, wave, QN);
    att::attn_phase<0, PROBE_AV>((char*)lds_raw, Qb, ws + WS_KV, ws + WS_NQ, ws + WS_KPE, YA, 2 * G, bx + G, wave, QN);
    att::attn_phase<1, PROBE_AV>((char*)lds_raw, Qb, ws + WS_KV, ws + WS_NQ, ws + WS_KPE, YA, 2 * G, bx + G, wave, QN);
}
#endif

extern "C" void kernel_launch(void* const* d_in, const int* in_sizes, int n_in, void* d_out, int out_size, void* d_ws, size_t ws_size, hipStream_t stream) {
    static int grid = 0;
    if (grid == 0) {
        if (n_in != 22 || out_size != T * DM || ws_size < WS_END) { fprintf(stderr, "kernel_launch: unexpected shapes (n_in %d, out %d, ws %zu)\n", n_in, out_size, ws_size); grid = -1; return; }
        int dev = 0, cus = 0, per_cu = 0;
        if (hipGetDevice(&dev) != hipSuccess || hipDeviceGetAttribute(&cus, hipDeviceAttributeMultiprocessorCount, dev) != hipSuccess) { grid = -1; return; }
        if (hipFuncSetAttribute((const void*)fwd_kernel, hipFuncAttributeMaxDynamicSharedMemorySize, LDS_BYTES) != hipSuccess) { fprintf(stderr, "kernel_launch: hipFuncSetAttribute failed\n"); grid = -1; return; }
        if (hipOccupancyMaxActiveBlocksPerMultiprocessor(&per_cu, (const void*)fwd_kernel, 512, LDS_BYTES) != hipSuccess || per_cu < 1) fprintf(stderr, "kernel_launch: occupancy query reports %d\n", per_cu);
        (void)hipGetLastError();
        grid = cus;
    }
    if (grid < 0) return;
    (void)hipMemsetAsync((char*)d_ws + WS_CTL, 0, CTL_ZERO_BYTES, stream);
    Params p{};
    for (int i = 0; i < 22; ++i) p.in[i] = (const float*)d_in[i];
    p.out = (float*)d_out; p.ws = (unsigned char*)d_ws;
    for (int li = 0; li < N_LAUNCHES; ++li) {
        if (N_LAUNCHES == 1) { p.ph_lo = 0; p.ph_hi = NPH; } else { p.ph_lo = li; p.ph_hi = li + 1; }
        hipLaunchKernelGGL(fwd_kernel, dim3(grid), dim3(512), LDS_BYTES, stream, p);
    }
#if PROBE_AV >= 0
    (void)hipFuncSetAttribute((const void*)probe_attn_kernel, hipFuncAttributeMaxDynamicSharedMemorySize, LDS_BYTES);
    hipLaunchKernelGGL(probe_attn_kernel, dim3(grid), dim3(512), LDS_BYTES, stream, p);
#endif
    if (PROBE_PHASE >= 0) { p.ph_lo = PROBE_PHASE; p.ph_hi = PROBE_PHASE + 1; hipLaunchKernelGGL(fwd_kernel, dim3(grid), dim3(512), LDS_BYTES, stream, p); }
}
```
